# Optimizing an MI355X kernel written in HIP

```python
import math
import jax, jax.numpy as jnp
from jax import lax
import numpy as np

D_MODEL = 1024
BATCH = 8
SEQ = 2048
DEPTH = 4

CHUNK = 64
N_MIXERS = 3
D_FF = 4 * D_MODEL
NORM_EPS = 1e-6
GDN_HEADS = 8
GDN_DK = D_MODEL // GDN_HEADS
GDN_DV = D_MODEL // GDN_HEADS
GDN_CONV = 4
GDN_QKV = GDN_HEADS * (2 * GDN_DK + GDN_DV)
GDN_IN = GDN_QKV + GDN_HEADS * GDN_DV + 2 * GDN_HEADS
MLSTM_HEADS = 8
MLSTM_DV = D_MODEL // MLSTM_HEADS
MLSTM_DK = MLSTM_DV // 2
GATE_CAP = 15.0
MLSTM_IN = MLSTM_HEADS * (2 * MLSTM_DK + 2 * MLSTM_DV) + 2 * MLSTM_HEADS
DIFF_HEADS = 8
DIFF_D = D_MODEL // (2 * DIFF_HEADS)
ROPE_THETA = 500000.0
ROT_DIMS = DIFF_D // 4
Q_BLOCK = 128
N_GDN = (DEPTH + 2) // 3
N_MLSTM = (DEPTH + 1) // 3
N_DIFF = DEPTH // 3

kernel_name = "hybrid_gdn_mlstm_diffattn_trunk"


def rms_norm(x, g):
    xf = x.astype(jnp.float32)
    y = xf * lax.rsqrt(jnp.mean(xf * xf, axis=-1, keepdims=True) + NORM_EPS)
    return (y * g.astype(jnp.float32)).astype(x.dtype)


def l2_norm(x):
    xf = x.astype(jnp.float32)
    return xf * lax.rsqrt(jnp.sum(xf * xf, axis=-1, keepdims=True) + NORM_EPS)


def soft_cap(x):
    return GATE_CAP * jnp.tanh(x / GATE_CAP)


def to_chunks(x):
    b, t, h = x.shape[:3]
    x = x.reshape((b, t // CHUNK, CHUNK, h) + x.shape[3:])
    return jnp.swapaxes(jnp.moveaxis(x, 1, 0), 2, 3)


def from_chunks(x):
    n, b, h, c, d = x.shape
    return jnp.moveaxis(jnp.swapaxes(x, 2, 3), 0, 1).reshape(b, n * c, h, d)


def causal_conv(x, w):
    width, t = w.shape[0], x.shape[1]
    xp = jnp.pad(x, ((0, 0), (width - 1, 0), (0, 0)))
    return sum(xp[:, j:j + t] * w[j] for j in range(width))


def partial_rope(x, cos, sin):
    shp = (1, x.shape[1]) + (1,) * (x.ndim - 3) + (ROT_DIMS // 2,)
    c, s = cos.reshape(shp), sin.reshape(shp)
    x1, x2, rest = x[..., :ROT_DIMS // 2], x[..., ROT_DIMS // 2:ROT_DIMS], x[..., ROT_DIMS:]
    return jnp.concatenate([x1 * c - x2 * s, x1 * s + x2 * c, rest], axis=-1)


def gated_delta_rule(q, k, v, g, beta):
    dk, dv = q.shape[-1], v.shape[-1]
    qc = to_chunks(q * dk ** -0.5)
    kc = to_chunks(k)
    vc = to_chunks(v.astype(jnp.float32))
    gc = jnp.cumsum(to_chunks(g.astype(jnp.float32)), axis=-1)
    bc = to_chunks(beta.astype(jnp.float32))
    tril = jnp.tril(jnp.ones((CHUNK, CHUNK), bool))
    strict = jnp.tril(jnp.ones((CHUNK, CHUNK), bool), -1)
    diff = gc[..., :, None] - gc[..., None, :]
    decay = jnp.where(tril, jnp.exp(jnp.where(tril, diff, 0.0)), 0.0)
    kb = kc * bc[..., None]
    a_mat = jnp.where(strict, jnp.einsum('nbhid,nbhjd->nbhij', kb, kc) * decay, 0.0)
    t_mat = a_mat + jnp.eye(CHUNK, dtype=jnp.float32)
    rhs = jnp.concatenate([vc * bc[..., None], kb * jnp.exp(gc)[..., None]], axis=-1)
    sol = lax.linalg.triangular_solve(t_mat, rhs, left_side=True, lower=True, unit_diagonal=True)
    value, kcd = sol[..., :dv], sol[..., dv:]
    attn = jnp.einsum('nbhid,nbhjd->nbhij', qc, kc) * decay
    q_inter = qc * jnp.exp(gc)[..., None]
    g_last = gc[..., -1]
    k_state = kc * jnp.exp(g_last[..., None] - gc)[..., None]

    def step(s_st, xs):
        qi, kcd_i, val_i, attn_i, kst_i, gl_i = xs
        v_new = val_i - jnp.einsum('bhck,bhkv->bhcv', kcd_i, s_st)
        o = jnp.einsum('bhck,bhkv->bhcv', qi, s_st) + jnp.einsum('bhcs,bhsv->bhcv', attn_i, v_new)
        s_st = s_st * jnp.exp(gl_i)[..., None, None] + jnp.einsum('bhck,bhcv->bhkv', kst_i, v_new)
        return s_st, o

    s0 = jnp.zeros(qc.shape[1:3] + (dk, dv), jnp.float32)
    _, o = lax.scan(step, s0, (q_inter, kcd, value, attn, k_state, g_last))
    return from_chunks(o)


def gdn_mixer(h, w_in, conv_w, a_log, dt_bias, norm_g, w_out):
    b, t, _ = h.shape
    proj = h @ w_in
    qkv = jax.nn.silu(causal_conv(proj[..., :GDN_QKV], conv_w))
    z = proj[..., GDN_QKV:GDN_QKV + GDN_HEADS * GDN_DV].reshape(b, t, GDN_HEADS, GDN_DV)
    a = proj[..., GDN_QKV + GDN_HEADS * GDN_DV:GDN_IN - GDN_HEADS]
    bt = proj[..., GDN_IN - GDN_HEADS:]
    hk = GDN_HEADS * GDN_DK
    q = l2_norm(qkv[..., :hk].reshape(b, t, GDN_HEADS, GDN_DK))
    k = l2_norm(qkv[..., hk:2 * hk].reshape(b, t, GDN_HEADS, GDN_DK))
    v = qkv[..., 2 * hk:].reshape(b, t, GDN_HEADS, GDN_DV)
    g = -jnp.exp(a_log.astype(jnp.float32)) * jax.nn.softplus((a + dt_bias).astype(jnp.float32))
    beta = jax.nn.sigmoid(bt.astype(jnp.float32))
    o = gated_delta_rule(q, k, v, g, beta)
    o = rms_norm(o, norm_g) * jax.nn.silu(z.astype(jnp.float32))
    return o.reshape(b, t, GDN_HEADS * GDN_DV).astype(h.dtype) @ w_out


def mlstm_chunkwise(q, k, v, i_pre, f_pre):
    dk, dv = q.shape[-1], v.shape[-1]
    qc = to_chunks(q.astype(jnp.float32) * dk ** -0.5)
    kc = to_chunks(k.astype(jnp.float32))
    vc = to_chunks(v.astype(jnp.float32))
    lfc = to_chunks(jax.nn.log_sigmoid(f_pre.astype(jnp.float32)))
    ic = to_chunks(i_pre.astype(jnp.float32))
    tril = jnp.tril(jnp.ones((CHUNK, CHUNK), bool))

    def step(carry, xs):
        c_st, n_st, m_st = carry
        q_, k_, v_, lf, ig = xs
        bcum = jnp.cumsum(lf, axis=-1)
        g = bcum[..., -1]
        dlog = jnp.where(tril, bcum[..., :, None] - bcum[..., None, :] + ig[..., None, :], -jnp.inf)
        m_inter = bcum + m_st[..., None]
        m_out = jnp.maximum(m_inter, jnp.max(dlog, axis=-1))
        w_inter = jnp.exp(m_inter - m_out)
        s = jnp.einsum('bhtd,bhsd->bhts', q_, k_) * jnp.exp(dlog - m_out[..., None])
        num = w_inter[..., None] * jnp.einsum('bhtd,bhde->bhte', q_, c_st) + jnp.einsum('bhts,bhse->bhte', s, v_)
        den = w_inter * jnp.einsum('bhtd,bhd->bht', q_, n_st) + jnp.sum(s, axis=-1)
        h_ = num / jnp.maximum(jnp.abs(den), jnp.exp(-m_out))[..., None]
        a = g[..., None] - bcum + ig
        m_new = jnp.maximum(g + m_st, jnp.max(a, axis=-1))
        w_old = jnp.exp(g + m_st - m_new)
        kw = k_ * jnp.exp(a - m_new[..., None])[..., None]
        c_new = w_old[..., None, None] * c_st + jnp.einsum('bhsd,bhse->bhde', kw, v_)
        n_new = w_old[..., None] * n_st + jnp.sum(kw, axis=-2)
        return (c_new, n_new, m_new), h_

    bh = qc.shape[1:3]
    init = (jnp.zeros(bh + (dk, dv), jnp.float32), jnp.zeros(bh + (dk,), jnp.float32),
            jnp.zeros(bh, jnp.float32))
    _, hs = lax.scan(step, init, (qc, kc, vc, lfc, ic))
    return from_chunks(hs)


def mlstm_mixer(h, w_in, gate_b, norm_g, w_out):
    b, t, _ = h.shape
    proj = h @ w_in
    hk, hv = MLSTM_HEADS * MLSTM_DK, MLSTM_HEADS * MLSTM_DV
    q = proj[..., :hk].reshape(b, t, MLSTM_HEADS, MLSTM_DK)
    k = proj[..., hk:2 * hk].reshape(b, t, MLSTM_HEADS, MLSTM_DK)
    v = proj[..., 2 * hk:2 * hk + hv].reshape(b, t, MLSTM_HEADS, MLSTM_DV)
    o_gate = proj[..., 2 * hk + hv:2 * hk + 2 * hv]
    i_pre = soft_cap(proj[..., MLSTM_IN - 2 * MLSTM_HEADS:MLSTM_IN - MLSTM_HEADS] + gate_b[0])
    f_pre = soft_cap(proj[..., MLSTM_IN - MLSTM_HEADS:] + gate_b[1])
    hc = mlstm_chunkwise(q, k, v, i_pre, f_pre)
    hn = rms_norm(hc, norm_g.reshape(MLSTM_HEADS, MLSTM_DV)).reshape(b, t, hv)
    return (jax.nn.sigmoid(o_gate.astype(jnp.float32)) * hn).astype(h.dtype) @ w_out


def diff_attention(q, k, v, lam):
    b, t, h, _, d = q.shape
    nq = t // Q_BLOCK
    qf = jnp.moveaxis((q.astype(jnp.float32) * d ** -0.5).reshape(b, nq, Q_BLOCK, h, 2, d), 1, 0)
    kf, vf = k.astype(jnp.float32), v.astype(jnp.float32)
    key_chunk = jnp.arange(t) // CHUNK

    def one_block(args):
        qb, idx = args
        q_chunk = (idx * Q_BLOCK + jnp.arange(Q_BLOCK)) // CHUNK
        s = jnp.einsum('bqhcd,bkhcd->bhcqk', qb, kf)
        mask = key_chunk[None, :] <= q_chunk[:, None]
        p = jax.nn.softmax(jnp.where(mask, s, -jnp.inf), axis=-1)
        attn = p[:, :, 0] - lam * p[:, :, 1]
        return jnp.einsum('bhqk,bkhe->bqhe', attn, vf)

    o = lax.map(one_block, (qf, jnp.arange(nq)))
    return jnp.moveaxis(o, 0, 1).reshape(b, t, h, 2 * d)


def diff_mixer(h, w_in, lam_p, norm_g, w_out, lambda_init, cos, sin):
    b, t, _ = h.shape
    proj = h @ w_in
    hq = DIFF_HEADS * 2 * DIFF_D
    q = partial_rope(proj[..., :hq].reshape(b, t, DIFF_HEADS, 2, DIFF_D), cos, sin)
    k = partial_rope(proj[..., hq:2 * hq].reshape(b, t, DIFF_HEADS, 2, DIFF_D), cos, sin)
    v = proj[..., 2 * hq:].reshape(b, t, DIFF_HEADS, 2 * DIFF_D)
    lp = lam_p.astype(jnp.float32)
    lam = jnp.exp(jnp.sum(lp[0] * lp[1])) - jnp.exp(jnp.sum(lp[2] * lp[3])) + lambda_init
    o = diff_attention(q, k, v, lam)
    o = rms_norm(o, norm_g) * (1.0 - lambda_init)
    return o.reshape(b, t, hq).astype(h.dtype) @ w_out


def sq_relu_mlp(h, w1, w2):
    return jnp.square(jax.nn.relu(h @ w1)) @ w2


def setup_inputs(seed: int = 0) -> dict:
    key = jax.random.key(seed)
    ks = jax.random.split(key, 18)
    nrm = lambda k, shape, scale: jax.random.normal(k, shape, jnp.float32) * scale
    return {
        "x": nrm(ks[0], (BATCH, SEQ, D_MODEL), 1.0),
        "norm_g": 1.0 + nrm(ks[1], (DEPTH, 4, D_MODEL), 0.05),
        "mlp_w1": nrm(ks[2], (DEPTH, D_MODEL, D_FF), D_MODEL ** -0.5),
        "mlp_w2": nrm(ks[3], (DEPTH, D_FF, D_MODEL), D_FF ** -0.5),
        "gdn_w_in": nrm(ks[4], (N_GDN, D_MODEL, GDN_IN), D_MODEL ** -0.5),
        "gdn_conv": nrm(ks[5], (N_GDN, GDN_CONV, GDN_QKV), GDN_CONV ** -0.5),
        "gdn_a_log": jnp.log(jax.random.uniform(ks[6], (N_GDN, GDN_HEADS), jnp.float32, 1.0, 16.0)),
        "gdn_dt_bias": -4.0 + nrm(ks[7], (N_GDN, GDN_HEADS), 0.5),
        "gdn_norm_g": 1.0 + nrm(ks[8], (N_GDN, GDN_DV), 0.05),
        "gdn_w_out": nrm(ks[9], (N_GDN, GDN_HEADS * GDN_DV, D_MODEL), (GDN_HEADS * GDN_DV) ** -0.5),
        "mlstm_w_in": nrm(ks[10], (N_MLSTM, D_MODEL, MLSTM_IN), D_MODEL ** -0.5),
        "mlstm_gate_b": jnp.array([[-1.0], [3.0]], jnp.float32) + nrm(ks[11], (N_MLSTM, 2, MLSTM_HEADS), 0.1),
        "mlstm_norm_g": 1.0 + nrm(ks[12], (N_MLSTM, MLSTM_HEADS * MLSTM_DV), 0.05),
        "mlstm_w_out": nrm(ks[13], (N_MLSTM, MLSTM_HEADS * MLSTM_DV, D_MODEL), (MLSTM_HEADS * MLSTM_DV) ** -0.5),
        "diff_w_in": nrm(ks[14], (N_DIFF, D_MODEL, 3 * DIFF_HEADS * 2 * DIFF_D), D_MODEL ** -0.5),
        "diff_lambda": nrm(ks[15], (N_DIFF, 4, DIFF_D), 0.1),
        "diff_norm_g": 1.0 + nrm(ks[16], (N_DIFF, 2 * DIFF_D), 0.05),
        "diff_w_out": nrm(ks[17], (N_DIFF, DIFF_HEADS * 2 * DIFF_D, D_MODEL), (DIFF_HEADS * 2 * DIFF_D) ** -0.5),
    }


def reference(x, norm_g, mlp_w1, mlp_w2, gdn_w_in, gdn_conv, gdn_a_log, gdn_dt_bias, gdn_norm_g,
              gdn_w_out, mlstm_w_in, mlstm_gate_b, mlstm_norm_g, mlstm_w_out, diff_w_in,
              diff_lambda, diff_norm_g, diff_w_out):
    t = x.shape[1]
    inv_freq = ROPE_THETA ** (-jnp.arange(0, ROT_DIMS, 2, dtype=jnp.float32) / ROT_DIMS)
    ang = jnp.arange(t, dtype=jnp.float32)[:, None] * inv_freq[None, :]
    cos, sin = jnp.cos(ang).astype(x.dtype), jnp.sin(ang).astype(x.dtype)
    for i in range(DEPTH):
        kind, j = i % N_MIXERS, i // N_MIXERS
        h = rms_norm(x, norm_g[i, 0])
        if kind == 0:
            m = gdn_mixer(h, gdn_w_in[j], gdn_conv[j], gdn_a_log[j], gdn_dt_bias[j], gdn_norm_g[j], gdn_w_out[j])
        elif kind == 1:
            m = mlstm_mixer(h, mlstm_w_in[j], mlstm_gate_b[j], mlstm_norm_g[j], mlstm_w_out[j])
        else:
            lambda_init = 0.8 - 0.6 * math.exp(-0.3 * i)
            m = diff_mixer(h, diff_w_in[j], diff_lambda[j], diff_norm_g[j], diff_w_out[j], lambda_init, cos, sin)
        x = x + rms_norm(m, norm_g[i, 1])
        h = rms_norm(x, norm_g[i, 2])
        x = x + rms_norm(sq_relu_mlp(h, mlp_w1[i], mlp_w2[i]), norm_g[i, 3])
    return x
```

```cpp
#ifndef HOST_EMU
#include <hip/hip_runtime.h>
#endif
#include <cstdio>
#include <cstdint>
#include <cstddef>

#ifndef CFG_B
#define CFG_B 8
#endif
#ifndef CFG_T
#define CFG_T 2048
#endif

#ifdef HOST_EMU
#define DEVI static inline
#define LAS
#define GAS
#define __expf expf
#define WAVE_SYNC() emu_wave_sync()
#define WG_BAR() emu_block_sync()
DEVI float u2f(unsigned u) { float f; memcpy(&f, &u, 4); return f; }
DEVI unsigned f2u(float f) { unsigned u; memcpy(&u, &f, 4); return u; }
DEVI float fast_exp2(float x) { return exp2f(x); }
DEVI float fast_rcp(float x) { return 1.0f / x; }
DEVI float fast_rsq(float x) { return 1.0f / sqrtf(x); }
#else
#define DEVI __device__ __forceinline__
#define LAS __attribute__((address_space(3)))
#define GAS __attribute__((address_space(1)))
#define WAVE_SYNC() asm volatile("s_waitcnt lgkmcnt(0)" ::: "memory")
#define WG_BAR() __syncthreads()
typedef short bf16x8 __attribute__((ext_vector_type(8)));
typedef short s16x4 __attribute__((ext_vector_type(4)));
typedef float f32x4 __attribute__((ext_vector_type(4)));
typedef float f32x16 __attribute__((ext_vector_type(16)));
DEVI float u2f(unsigned u) { return __uint_as_float(u); }
DEVI unsigned f2u(float f) { return __float_as_uint(f); }
DEVI float fast_exp2(float x) { return __builtin_amdgcn_exp2f(x); }
DEVI float fast_rcp(float x) { return __builtin_amdgcn_rcpf(x); }
DEVI float fast_rsq(float x) { return __builtin_amdgcn_rsqf(x); }
#endif
typedef unsigned short bf16;
typedef unsigned u32x4 __attribute__((ext_vector_type(4)));
typedef unsigned u32x2 __attribute__((ext_vector_type(2)));
typedef float f32x2 __attribute__((ext_vector_type(2)));

DEVI f32x16 MFMA32(bf16x8 a, bf16x8 b, f32x16 c) {
#ifdef HOST_EMU
    return emu_mfma32(a, b, c);
#else
    return __builtin_amdgcn_mfma_f32_32x32x16_bf16(a, b, c, 0, 0, 0);
#endif
}
DEVI f32x4 MFMA16(bf16x8 a, bf16x8 b, f32x4 c) {
#ifdef HOST_EMU
    return emu_mfma16(a, b, c);
#else
    return __builtin_amdgcn_mfma_f32_16x16x32_bf16(a, b, c, 0, 0, 0);
#endif
}
DEVI float wshfl(float v, int src) {
#ifdef HOST_EMU
    return emu_shfl_f(v, src);
#else
    return __shfl(v, src);
#endif
}
DEVI unsigned wshfl_u(unsigned v, int src) {
#ifdef HOST_EMU
    return emu_shfl_u(v, src);
#else
    return (unsigned)__shfl((int)v, src);
#endif
}
DEVI int opaque(int v) {
#ifndef HOST_EMU
    asm volatile("" : "+v"(v));
#endif
    return v;
}
DEVI int my_lane() {
#ifdef HOST_EMU
    return t_lane;
#else
    return opaque((int)(threadIdx.x & 63));
#endif
}
DEVI float wshfl_xor(float v, int m) { return wshfl(v, my_lane() ^ m); }
DEVI unsigned wshfl_xor_u(unsigned v, int m) { return wshfl_u(v, my_lane() ^ m); }
DEVI float wshfl_up(float v, int d) { const int l = my_lane(); const float r = wshfl(v, l >= d ? l - d : l); return r; }

DEVI unsigned f2bf(float f) { unsigned u = f2u(f); return (u + 0x7fffu + ((u >> 16) & 1u)) >> 16; }
DEVI float bf2f(unsigned b) { return u2f(b << 16); }
DEVI unsigned pk2(float lo, float hi) {
#ifdef HOST_EMU
    return f2bf(lo) | (f2bf(hi) << 16);
#else
    typedef __bf16 bf16x2_t __attribute__((ext_vector_type(2)));
    f32x2 v = {lo, hi}; bf16x2_t b = __builtin_convertvector(v, bf16x2_t); return __builtin_bit_cast(unsigned, b);
#endif
}
DEVI bf16x8 pack8f(float a0, float a1, float a2, float a3, float a4, float a5, float a6, float a7) {
    u32x4 p; p.x = pk2(a0, a1); p.y = pk2(a2, a3); p.z = pk2(a4, a5); p.w = pk2(a6, a7);
    return __builtin_bit_cast(bf16x8, p);
}
#define PACK_ACC(x, s) pack8f((x)[8 * (s) + 0], (x)[8 * (s) + 1], (x)[8 * (s) + 2], (x)[8 * (s) + 3], (x)[8 * (s) + 4], (x)[8 * (s) + 5], (x)[8 * (s) + 6], (x)[8 * (s) + 7])
DEVI int crow(int reg, int hi) { return (reg & 3) + 8 * (reg >> 2) + 4 * hi; }
DEVI f32x16 zero16() { f32x16 z;
#pragma unroll
    for (int i = 0; i < 16; ++i) z[i] = 0.f; return z; }

DEVI bf16x8 gld16(const bf16* p) { return *(const GAS bf16x8*)p; }
DEVI void gst16(bf16* p, bf16x8 v) { *(GAS bf16x8*)p = v; }
DEVI s16x4 gld8(const bf16* p) { return *(const GAS s16x4*)p; }
DEVI void gst8(bf16* p, s16x4 v) { *(GAS s16x4*)p = v; }
DEVI float gldf(const float* p) { return *(const GAS float*)p; }
DEVI f32x4 gldf4(const float* p) { return *(const GAS f32x4*)p; }
DEVI void gstf4(float* p, f32x4 v) { *(GAS f32x4*)p = v; }
DEVI bf16x8 cat8(s16x4 lo, s16x4 hi) { return __builtin_shufflevector(lo, hi, 0, 1, 2, 3, 4, 5, 6, 7); }

constexpr int NB = CFG_B, SEQ = CFG_T, M = NB * SEQ, D = 1024, FF = 4096, NH = 8;
constexpr int NCH = SEQ / 64, NCG = M / 64, NITEM = NCG * NH;
constexpr float NORM_EPS = 1e-6f;
constexpr int GDN_IN = 4112, MLSTM_IN = 3088, DIFF_IN = 3072;
constexpr float LOG2E = 1.4426950408889634f;

struct Frame { LAS unsigned char* lds; int tid, lane, wave, vcu, G; };
constexpr int WAVE_LDS = 18432;
constexpr int WAVE_SM = 17408;

DEVI float wave_sum(float v) {
#pragma unroll
    for (int o = 1; o < 64; o <<= 1) v += wshfl_xor(v, o);
    return v;
}
DEVI float wave_max(float v) {
#pragma unroll
    for (int o = 1; o < 64; o <<= 1) v = fmaxf(v, wshfl_xor(v, o));
    return v;
}
DEVI float silu_f(float x) { return x / (1.0f + __expf(-x)); }
DEVI float sigmoid_f(float x) { return 1.0f / (1.0f + __expf(-x)); }

DEVI int tile_off(int row, int piece) { return row * 272 + (piece << 4); }
DEVI bf16x8 tile_frag(const LAS unsigned char* buf, int row, int piece) { return *(const LAS bf16x8*)(buf + tile_off(row, piece)); }
DEVI unsigned tile_elem(const LAS unsigned char* buf, int row, int col) { return *(const LAS unsigned short*)(buf + tile_off(row, col >> 3) + (col & 7) * 2); }
DEVI bf16x8 tile_frag_T(const LAS unsigned char* buf, int col, int tj, int s, int h2) {
    const int t0 = 32 * tj + 16 * s + 4 * h2;
    unsigned e[8];
#pragma unroll
    for (int j = 0; j < 8; ++j) e[j] = tile_elem(buf, t0 + (j & 3) + 8 * (j >> 2), col);
    u32x4 p; p.x = e[0] | (e[1] << 16); p.y = e[2] | (e[3] << 16); p.z = e[4] | (e[5] << 16); p.w = e[6] | (e[7] << 16);
    return __builtin_bit_cast(bf16x8, p);
}
DEVI bf16x8 tile_frag_P(const LAS unsigned char* buf, int row, int td, int s, int h2) {
    const int p0 = 4 * td + 2 * s;
    const s16x4 lo = *(const LAS s16x4*)(buf + tile_off(row, p0) + 8 * h2);
    const s16x4 hi = *(const LAS s16x4*)(buf + tile_off(row, p0 + 1) + 8 * h2);
    return cat8(lo, hi);
}
DEVI bf16x8 ident_frag(int kk, int r32, int h2) {
    bf16x8 v;
#pragma unroll
    for (int j = 0; j < 8; ++j) v[j] = (16 * kk + 8 * h2 + j == r32) ? (short)0x3F80 : (short)0;
    return v;
}
DEVI void unpack8(bf16x8 v, float (&f)[8]) {
#pragma unroll
    for (int j = 0; j < 8; ++j) f[j] = bf2f((unsigned short)v[j]);
}

struct GdnArgs {
    bf16* P;
    const float* gates;
    const bf16* halo;
    const float* conv_w;
    const float* a_log; const float* dt_bias; const float* norm_g;
    bf16* kst;
    bf16* attn;
    float* dec;
    bf16* o;
};
constexpr int GP_LD = 4096;

DEVI void gdn_conv_tile(const GdnArgs& A, int which, int cg, int h, int lane, LAS unsigned char* buf, bool norm) {
    const int tq = lane >> 4, c8 = lane & 15, cb = which * 1024 + h * 128 + c8 * 8;
    const int n = cg % NCH;
    float w[4][8];
#pragma unroll
    for (int j = 0; j < 4; ++j) { const f32x4 a = gldf4(A.conv_w + j * 3072 + cb), b = gldf4(A.conv_w + j * 3072 + cb + 4);
        w[j][0] = a.x; w[j][1] = a.y; w[j][2] = a.z; w[j][3] = a.w; w[j][4] = b.x; w[j][5] = b.y; w[j][6] = b.z; w[j][7] = b.w; }
    const int t0 = tq * 16;
    const bf16* rowp = A.P + (size_t)(cg * 64 + t0) * GP_LD + cb;
    float x3[8], x2[8], x1[8];
    if (tq > 0) {
        unpack8(gld16(rowp - 3 * GP_LD), x3); unpack8(gld16(rowp - 2 * GP_LD), x2); unpack8(gld16(rowp - 1 * GP_LD), x1);
    } else if (n > 0) {
        const bf16* hp = A.halo + (size_t)(cg - 1) * 3 * 3072 + cb;
        unpack8(gld16(hp), x3); unpack8(gld16(hp + 3072), x2); unpack8(gld16(hp + 2 * 3072), x1);
    } else {
#pragma unroll
        for (int e = 0; e < 8; ++e) { x3[e] = 0.f; x2[e] = 0.f; x1[e] = 0.f; }
    }
#pragma unroll 4
    for (int i = 0; i < 16; ++i) {
        float xc[8], y[8];
        unpack8(gld16(rowp + (size_t)i * GP_LD), xc);
        float ss = 0.f;
#pragma unroll
        for (int e = 0; e < 8; ++e) { const float v = w[0][e] * x3[e] + w[1][e] * x2[e] + w[2][e] * x1[e] + w[3][e] * xc[e]; y[e] = silu_f(v); ss += y[e] * y[e]; x3[e] = x2[e]; x2[e] = x1[e]; x1[e] = xc[e]; }
        if (norm) {
            ss += wshfl_xor(ss, 1); ss += wshfl_xor(ss, 2); ss += wshfl_xor(ss, 4); ss += wshfl_xor(ss, 8);
            const float r = 1.0f / sqrtf(ss + NORM_EPS);
#pragma unroll
            for (int e = 0; e < 8; ++e) y[e] *= r;
        }
        const int row = t0 + i;
        *(LAS bf16x8*)(buf + tile_off(row, c8)) = pack8f(y[0], y[1], y[2], y[3], y[4], y[5], y[6], y[7]);
    }
}

DEVI bf16* gdn_fp(bf16* P, int cg, int col0, int c16) { return P + (size_t)(cg * 64 + (c16 >> 4)) * GP_LD + col0 + (c16 & 15) * 8; }

DEVI void gdn_prep_item(const GdnArgs& A, int item, int lane_in, LAS unsigned char* wl) {
    LAS unsigned char* buf = wl;
    LAS float* gcA = (LAS float*)(wl + WAVE_SM);
    LAS float* btA = gcA + 64;
    LAS float* wkA = gcA + 128;
    const int cg = item / NH, h = item % NH, m0 = cg * 64;
    int lane = opaque(lane_in), r32 = lane & 31, hi = lane >> 5;
#define RELANE() do { lane = opaque(lane); r32 = lane & 31; hi = lane >> 5; } while (0)
    float beta, eg;
    {
        const float a = gldf(A.gates + (size_t)(m0 + lane) * 16 + h), bt = gldf(A.gates + (size_t)(m0 + lane) * 16 + 8 + h);
        const float xs = a + gldf(A.dt_bias + h);
        const float sp = xs > 20.f ? xs : log1pf(__expf(xs));
        const float g = -__expf(gldf(A.a_log + h)) * sp;
        beta = sigmoid_f(bt);
        float gc = g;
#pragma unroll
        for (int d = 1; d < 64; d <<= 1) { const float o = wshfl_up(gc, d); if (lane >= d) gc += o; }
        const float glast = wshfl(gc, 63);
        eg = __expf(gc);
        gcA[lane] = gc; btA[lane] = beta; wkA[lane] = __expf(glast - gc);
        if (lane == 0) A.dec[item] = __expf(glast);
    }
    WAVE_SYNC();
    gdn_conv_tile(A, 0, cg, h, lane, buf, true);
    WAVE_SYNC();
    RELANE();
#pragma unroll
    for (int ti = 0; ti < 2; ++ti) {
        const float sc = __expf(gcA[32 * ti + r32]) * 0.08838834764831845f;
#pragma unroll
        for (int td = 0; td < 4; ++td)
#pragma unroll
            for (int s = 0; s < 2; ++s) {
                float f[8]; unpack8(tile_frag_P(buf, 32 * ti + r32, td, s, hi), f);
                gst16(gdn_fp(A.P, cg, h * 128, ((ti * 4 + td) * 2 + s) * 64 + lane), pack8f(f[0] * sc, f[1] * sc, f[2] * sc, f[3] * sc, f[4] * sc, f[5] * sc, f[6] * sc, f[7] * sc));
            }
    }
    RELANE();
    bf16x8 qf[2][8];
#pragma unroll
    for (int ti = 0; ti < 2; ++ti)
#pragma unroll
        for (int ks = 0; ks < 8; ++ks) qf[ti][ks] = tile_frag(buf, 32 * ti + r32, 2 * ks + hi);
    WAVE_SYNC();
    gdn_conv_tile(A, 1, cg, h, lane, buf, true);
    WAVE_SYNC();
    RELANE();
    {
#pragma unroll
        for (int ti = 0; ti < 2; ++ti)
#pragma unroll
            for (int tj = 0; tj < 2; ++tj) {
                f32x16 acc = zero16();
                if (tj <= ti) {
#pragma unroll
                    for (int ks = 0; ks < 8; ++ks) acc = MFMA32(tile_frag(buf, 32 * tj + r32, 2 * ks + hi), qf[ti][ks], acc);
                    const int i = 32 * ti + r32; const float gci = gcA[i];
#pragma unroll
                    for (int r = 0; r < 16; ++r) { const int j = 32 * tj + crow(r, hi); const float dlt = fminf(gci - gcA[j], 0.f);
                        acc[r] = (j <= i) ? acc[r] * 0.08838834764831845f * __expf(dlt) : 0.f; }
                }
#pragma unroll
                for (int s = 0; s < 2; ++s) gst16(A.attn + (size_t)item * 4096 + (size_t)(((ti * 2 + tj) * 2 + s) * 64 + lane) * 8, PACK_ACC(acc, s));
            }
    }
    RELANE();
    f32x16 am[3];
    {
#pragma unroll
        for (int t = 0; t < 3; ++t) {
            const int ti = t ? 1 : 0, tj = t == 2 ? 1 : 0;
            f32x16 acc = zero16();
#pragma unroll
            for (int ks = 0; ks < 8; ++ks) acc = MFMA32(tile_frag(buf, 32 * ti + r32, 2 * ks + hi), tile_frag(buf, 32 * tj + r32, 2 * ks + hi), acc);
            const int j = 32 * tj + r32; const float gcj = gcA[j];
#pragma unroll
            for (int r = 0; r < 16; ++r) { const int i = 32 * ti + crow(r, hi); const float dlt = fminf(gcA[i] - gcj, 0.f);
                acc[r] = (j < i) ? acc[r] * btA[i] * __expf(dlt) : 0.f; }
            am[t] = acc;
        }
    }
    RELANE();
    bf16x8 kT[4][2][2];
    {
        const bf16x8 id0 = ident_frag(0, r32, hi), id1 = ident_frag(1, r32, hi);
#pragma unroll
        for (int td = 0; td < 4; ++td)
#pragma unroll
            for (int tj = 0; tj < 2; ++tj) {
                f32x16 acc = MFMA32(tile_frag(buf, 32 * tj + r32, 2 * (2 * td) + hi), id0, zero16());
                acc = MFMA32(tile_frag(buf, 32 * tj + r32, 2 * (2 * td + 1) + hi), id1, acc);
                kT[td][tj][0] = PACK_ACC(acc, 0); kT[td][tj][1] = PACK_ACC(acc, 1);
            }
    }
    WAVE_SYNC();
    RELANE();
    {
        LAS float* Am = (LAS float*)buf;
#pragma unroll
        for (int t = 0; t < 3; ++t) { const int ti = t ? 1 : 0, tj = t == 2 ? 1 : 0;
#pragma unroll
            for (int r = 0; r < 16; ++r) Am[(32 * ti + crow(r, hi)) * 64 + 32 * tj + r32] = am[t][r]; }
    }
    WAVE_SYNC();
    RELANE();
    float u[64];
    {
        const LAS float* Am = (const LAS float*)buf;
#pragma unroll
        for (int i = 0; i < 64; ++i) u[i] = 0.f;
#pragma unroll
        for (int i = 0; i < 64; ++i) {
            float acc = (i == lane) ? 1.f : 0.f;
#pragma unroll
            for (int j4 = 0; j4 < (i + 3) / 4; ++j4) {
                const f32x4 a = *(const LAS f32x4*)(Am + i * 64 + 4 * j4);
                acc -= a.x * u[4 * j4]; acc -= a.y * u[4 * j4 + 1]; acc -= a.z * u[4 * j4 + 2]; acc -= a.w * u[4 * j4 + 3];
            }
            u[i] = acc;
        }
    }
    WAVE_SYNC();
    RELANE();
    {
        const float sv = beta, sk = -beta * eg;
        LAS unsigned short* Uk = (LAS unsigned short*)buf; LAS unsigned short* Uv = (LAS unsigned short*)(buf + 8704);
#pragma unroll
        for (int i = 0; i < 64; ++i) { Uk[i * 68 + lane] = (unsigned short)f2bf(u[i] * sk); Uv[i * 68 + lane] = (unsigned short)f2bf(u[i] * sv); }
    }
    WAVE_SYNC();
    RELANE();
#pragma unroll
    for (int ti = 0; ti < 2; ++ti) {
        bf16x8 ukf[2][2];
#pragma unroll
        for (int tj = 0; tj < 2; ++tj)
#pragma unroll
            for (int s = 0; s < 2; ++s) { const int off = (32 * ti + r32) * 136 + (32 * tj + 16 * s + 4 * hi) * 2;
                ukf[tj][s] = cat8(*(const LAS s16x4*)(buf + off), *(const LAS s16x4*)(buf + off + 16)); }
#pragma unroll
        for (int td = 0; td < 4; ++td) {
            f32x16 acc = zero16();
#pragma unroll
            for (int tj = 0; tj < 2; ++tj)
#pragma unroll
                for (int s = 0; s < 2; ++s) acc = MFMA32(kT[td][tj][s], ukf[tj][s], acc);
#pragma unroll
            for (int s = 0; s < 2; ++s) gst16(gdn_fp(A.P, cg, 1024 + h * 128, ((ti * 4 + td) * 2 + s) * 64 + lane), PACK_ACC(acc, s));
        }
    }
    RELANE();
#pragma unroll
    for (int td = 0; td < 4; ++td)
#pragma unroll
        for (int tj = 0; tj < 2; ++tj)
#pragma unroll
            for (int s = 0; s < 2; ++s) {
                float f[8]; unpack8(kT[td][tj][s], f);
                const int t0 = 32 * tj + 16 * s + 4 * hi;
#pragma unroll
                for (int j = 0; j < 8; ++j) f[j] *= wkA[t0 + (j & 3) + 8 * (j >> 2)];
                gst16(A.kst + (size_t)item * 8192 + (size_t)(((td * 2 + tj) * 2 + s) * 64 + lane) * 8, pack8f(f[0], f[1], f[2], f[3], f[4], f[5], f[6], f[7]));
            }
    RELANE();
    bf16x8 uvf[2][2][2];
#pragma unroll
    for (int ti = 0; ti < 2; ++ti)
#pragma unroll
        for (int tj = 0; tj < 2; ++tj)
#pragma unroll
            for (int s = 0; s < 2; ++s) { const int off = 8704 + (32 * ti + r32) * 136 + (32 * tj + 16 * s + 4 * hi) * 2;
                uvf[ti][tj][s] = cat8(*(const LAS s16x4*)(buf + off), *(const LAS s16x4*)(buf + off + 16)); }
    WAVE_SYNC();
    gdn_conv_tile(A, 2, cg, h, lane, buf, false);
    WAVE_SYNC();
    RELANE();
    const bf16x8 idv0 = ident_frag(0, r32, hi), idv1 = ident_frag(1, r32, hi);
#pragma unroll
    for (int t4 = 0; t4 < 4; ++t4) {
        bf16x8 vT[2][2];
#pragma unroll
        for (int tj = 0; tj < 2; ++tj) {
            f32x16 acc = MFMA32(tile_frag(buf, 32 * tj + r32, 2 * (2 * t4) + hi), idv0, zero16());
            acc = MFMA32(tile_frag(buf, 32 * tj + r32, 2 * (2 * t4 + 1) + hi), idv1, acc);
            vT[tj][0] = PACK_ACC(acc, 0); vT[tj][1] = PACK_ACC(acc, 1);
        }
#pragma unroll
        for (int ti = 0; ti < 2; ++ti) {
            f32x16 acc = zero16();
#pragma unroll
            for (int tj = 0; tj < 2; ++tj)
#pragma unroll
                for (int s = 0; s < 2; ++s) acc = MFMA32(uvf[ti][tj][s], vT[tj][s], acc);
            const int c16 = ((t4 * 2 + ti) * 64 + lane) * 2;
            gst16(gdn_fp(A.P, cg, 2048 + h * 128, c16), PACK_ACC(acc, 0));
            gst16(gdn_fp(A.P, cg, 2048 + h * 128, c16 + 1), PACK_ACC(acc, 1));
        }
    }
    WAVE_SYNC();
#undef RELANE
}

DEVI void gdn_prep_phase(const Frame& F, const GdnArgs& A) {
    LAS unsigned char* wl = F.lds + F.wave * WAVE_LDS;
    for (int item = F.vcu * 8 + F.wave; item < NITEM; item += F.G * 8) gdn_prep_item(A, item, F.lane, wl);
}

DEVI void gdn_scan_phase(const Frame& F, const GdnArgs& A) {
    LAS float* ssb = (LAS float*)F.lds;
    const int w = F.wave;
    for (int bh = F.vcu; bh < NB * NH; bh += F.G) {
        const int b = bh / NH, h = bh % NH;
        f32x16 S[4]; bf16x8 Sf[4][2];
#pragma unroll
        for (int td = 0; td < 4; ++td) { S[td] = zero16(); Sf[td][0] = PACK_ACC(S[td], 0); Sf[td][1] = PACK_ACC(S[td], 1); }
        for (int n = 0; n < NCH; ++n) {
            const int cg = b * NCH + n, item = cg * NH + h;
            if (w < 4) {
                const int lane = opaque(F.lane), r32 = lane & 31, hi = lane >> 5;
                const int loff = (lane >> 4) * GP_LD + (lane & 15) * 8, l8 = lane * 8;
                const bf16* Pq = A.P + (size_t)cg * 64 * GP_LD + h * 128;
                const bf16* Pk = Pq + 1024; const bf16* Pv = Pq + 2048;
                const bf16* At = A.attn + (size_t)item * 4096; const bf16* Ks = A.kst + (size_t)item * 8192;
                f32x16 vn[2];
#pragma unroll
                for (int ti = 0; ti < 2; ++ti) {
                    const bf16* vp = Pv + (size_t)((w * 2 + ti) * 8 + (lane >> 3)) * GP_LD + (lane & 7) * 16;
                    float f0[8], f1[8]; unpack8(gld16(vp), f0); unpack8(gld16(vp + 8), f1);
#pragma unroll
                    for (int r = 0; r < 8; ++r) { vn[ti][r] = f0[r]; vn[ti][8 + r] = f1[r]; }
#pragma unroll
                    for (int td = 0; td < 4; ++td)
#pragma unroll
                        for (int s = 0; s < 2; ++s) vn[ti] = MFMA32(gld16(Pk + (size_t)(((ti * 4 + td) * 2 + s) * 4) * GP_LD + loff), Sf[td][s], vn[ti]);
                }
                bf16x8 vf[2][2];
#pragma unroll
                for (int tj = 0; tj < 2; ++tj) { vf[tj][0] = PACK_ACC(vn[tj], 0); vf[tj][1] = PACK_ACC(vn[tj], 1); }
                f32x16 oT[2];
#pragma unroll
                for (int ti = 0; ti < 2; ++ti) {
                    f32x16 acc = zero16();
#pragma unroll
                    for (int td = 0; td < 4; ++td)
#pragma unroll
                        for (int s = 0; s < 2; ++s) acc = MFMA32(Sf[td][s], gld16(Pq + (size_t)(((ti * 4 + td) * 2 + s) * 4) * GP_LD + loff), acc);
#pragma unroll
                    for (int tj = 0; tj < 2; ++tj)
#pragma unroll
                        for (int s = 0; s < 2; ++s) acc = MFMA32(vf[tj][s], gld16(At + (((ti * 2 + tj) * 2 + s) * 512) + l8), acc);
                    oT[ti] = acc;
                }
                const float dec = gldf(A.dec + item);
#pragma unroll
                for (int td = 0; td < 4; ++td) {
                    f32x16 acc = S[td] * dec;
#pragma unroll
                    for (int tj = 0; tj < 2; ++tj)
#pragma unroll
                        for (int s = 0; s < 2; ++s) acc = MFMA32(gld16(Ks + (((td * 2 + tj) * 2 + s) * 512) + l8), vf[tj][s], acc);
                    S[td] = acc; Sf[td][0] = PACK_ACC(acc, 0); Sf[td][1] = PACK_ACC(acc, 1);
                }
#pragma unroll
                for (int ti = 0; ti < 2; ++ti) {
                    float ss = 0.f;
#pragma unroll
                    for (int r = 0; r < 16; ++r) ss += oT[ti][r] * oT[ti][r];
                    ss += wshfl_xor(ss, 32);
                    if (hi == 0) ssb[((n & 1) * 4 + w) * 64 + 32 * ti + r32] = ss;
                }
                WG_BAR();
#pragma unroll
                for (int ti = 0; ti < 2; ++ti) {
                    const int tok = 32 * ti + r32;
                    const LAS float* sp = ssb + (n & 1) * 256 + tok;
                    const float tot = sp[0] + sp[64] + sp[128] + sp[192];
                    const float rs = 1.0f / sqrtf(tot * (1.0f / 128.0f) + NORM_EPS);
                    const size_t mrow = (size_t)(cg * 64 + tok);
#pragma unroll
                    for (int g = 0; g < 4; ++g) {
                        const int dv = 32 * w + 8 * g + 4 * hi;
                        const s16x4 zz = gld8(A.P + mrow * GP_LD + 3072 + h * 128 + dv);
                        const f32x4 gg = gldf4(A.norm_g + dv);
                        float o4[4];
#pragma unroll
                        for (int e = 0; e < 4; ++e) o4[e] = oT[ti][4 * g + e] * rs * gg[e] * silu_f(bf2f((unsigned short)zz[e]));
                        u32x2 pk; pk.x = pk2(o4[0], o4[1]); pk.y = pk2(o4[2], o4[3]);
                        gst8(A.o + mrow * 1024 + h * 128 + dv, __builtin_bit_cast(s16x4, pk));
                    }
                }
            } else {
                WG_BAR();
            }
        }
    }
}

struct MlArgs {
    bf16* P;
    const float* gates;
    const float* gate_b;
    const float* norm_g;
    bf16* pt;
    float* aux;
    bf16* o;
};
constexpr int MP_LD = 3072, ML_AUX = 320;
DEVI bf16* ml_fp128(bf16* P, int cg, int col0, int c16) { return P + (size_t)(cg * 64 + (c16 >> 3)) * MP_LD + col0 + (c16 & 7) * 8; }
DEVI bf16* ml_fp256(bf16* P, int cg, int col0, int c16) { return P + (size_t)(cg * 64 + (c16 >> 4)) * MP_LD + col0 + (c16 & 15) * 8; }
DEVI float softcap_f(float x) { return 15.0f * tanhf(x * (1.0f / 15.0f)); }
DEVI float logsig_f(float x) { return x >= 0.f ? -log1pf(__expf(-x)) : x - log1pf(__expf(x)); }

DEVI void ml_prep_item(const MlArgs& A, int item, int lane_in, LAS unsigned char* wl) {
    const int lane = opaque(lane_in);
    LAS unsigned char* buf = wl;
    LAS float* ctA = (LAS float*)(wl + WAVE_SM);
    LAS float* kwA = ctA + 64;
    const int cg = item / NH, h = item % NH, b = cg / NCH, n = cg % NCH, m0 = cg * 64;
    const int r32 = lane & 31, hi = lane >> 5;
    const float bi = gldf(A.gate_b + h), bf = gldf(A.gate_b + 8 + h);
    float mst = 0.f, bcum = 0.f, ig = 0.f, g = 0.f;
    for (int nn = 0; nn <= n; ++nn) {
        const size_t row = (size_t)((b * NCH + nn) * 64 + lane);
        ig = softcap_f(gldf(A.gates + row * 16 + h) + bi);
        const float lf = logsig_f(softcap_f(gldf(A.gates + row * 16 + 8 + h) + bf));
        bcum = lf;
#pragma unroll
        for (int d = 1; d < 64; d <<= 1) { const float o = wshfl_up(bcum, d); if (lane >= d) bcum += o; }
        g = wshfl(bcum, 63);
        if (nn < n) { const float amax = wave_max(g - bcum + ig); mst = fmaxf(g + mst, amax); }
    }
    const float a_s = g - bcum + ig;
    const float mnew = fmaxf(g + mst, wave_max(a_s));
    const float wold = __expf(g + mst - mnew);
    const float cterm = ig - bcum;
    float pmax = cterm;
#pragma unroll
    for (int d = 1; d < 64; d <<= 1) { const float o = wshfl_up(pmax, d); if (lane >= d) pmax = fmaxf(pmax, o); }
    const float minter = bcum + mst;
    const float mout = fmaxf(minter, bcum + pmax);
    const float winter = __expf(minter - mout);
    const float rterm = bcum - mout;
    ctA[lane] = cterm; kwA[lane] = __expf(a_s - mnew);
    float* aux = A.aux + (size_t)item * ML_AUX;
    aux[lane] = winter; aux[128 + lane] = __expf(-mout);
    if (lane == 0) aux[256] = wold;
    WAVE_SYNC();
    const float rt0 = wshfl(rterm, r32), rt1 = wshfl(rterm, 32 + r32);
    bf16x8 qB[2][4];
#pragma unroll
    for (int tt = 0; tt < 2; ++tt)
#pragma unroll
        for (int ks = 0; ks < 4; ++ks) qB[tt][ks] = gld16(A.P + (size_t)(m0 + 32 * tt + r32) * MP_LD + h * 64 + 16 * ks + 8 * hi);
    float csum0 = 0.f, csum1 = 0.f;
#pragma unroll
    for (int tt = 0; tt < 2; ++tt)
#pragma unroll
        for (int ts = 0; ts < 2; ++ts) {
            f32x16 acc = zero16();
            if (ts <= tt) {
#pragma unroll
                for (int ks = 0; ks < 4; ++ks) acc = MFMA32(gld16(A.P + (size_t)(m0 + 32 * ts + r32) * MP_LD + 512 + h * 64 + 16 * ks + 8 * hi), qB[tt][ks], acc);
                const int t = 32 * tt + r32; const float rt = tt ? rt1 : rt0;
                float cs = 0.f;
#pragma unroll
                for (int r = 0; r < 16; ++r) { const int s = 32 * ts + crow(r, hi);
                    acc[r] = (s <= t) ? acc[r] * 0.125f * __expf(fminf(rt + ctA[s], 0.f)) : 0.f; cs += acc[r]; }
                if (tt) csum1 += cs; else csum0 += cs;
            }
#pragma unroll
            for (int s2 = 0; s2 < 2; ++s2) gst16(A.pt + (size_t)item * 4096 + (size_t)(((tt * 2 + ts) * 2 + s2) * 64 + lane) * 8, PACK_ACC(acc, s2));
        }
    csum0 += wshfl_xor(csum0, 32); csum1 += wshfl_xor(csum1, 32);
    if (hi == 0) { aux[64 + r32] = csum0; aux[64 + 32 + r32] = csum1; }
    {
        const int lane = opaque(lane_in), r32 = lane & 31, hi = lane >> 5;
        bf16x8 qp[2][2][2];
#pragma unroll
        for (int tt = 0; tt < 2; ++tt)
#pragma unroll
            for (int td = 0; td < 2; ++td)
#pragma unroll
                for (int s = 0; s < 2; ++s) {
                    const bf16* p = A.P + (size_t)(m0 + 32 * tt + r32) * MP_LD + h * 64 + 32 * td + 16 * s + 4 * hi;
                    float f[8]; unpack8(cat8(gld8(p), gld8(p + 8)), f);
                    qp[tt][td][s] = pack8f(f[0] * 0.125f, f[1] * 0.125f, f[2] * 0.125f, f[3] * 0.125f, f[4] * 0.125f, f[5] * 0.125f, f[6] * 0.125f, f[7] * 0.125f);
                }
        WAVE_SYNC();
#pragma unroll
        for (int tt = 0; tt < 2; ++tt)
#pragma unroll
            for (int td = 0; td < 2; ++td)
#pragma unroll
                for (int s = 0; s < 2; ++s) gst16(ml_fp128(A.P, cg, h * 64, ((tt * 2 + td) * 2 + s) * 64 + lane), qp[tt][td][s]);
    }
    {
        const int lane = opaque(lane_in), r32 = lane & 31, hi = lane >> 5;
        const bf16x8 id0 = ident_frag(0, r32, hi), id1 = ident_frag(1, r32, hi);
        bf16x8 kwf[2][2][2]; float ks0 = 0.f, ks1 = 0.f;
#pragma unroll
        for (int td = 0; td < 2; ++td)
#pragma unroll
            for (int ts = 0; ts < 2; ++ts) {
                const bf16* kp = A.P + (size_t)(m0 + 32 * ts + r32) * MP_LD + 512 + h * 64 + 32 * td + 8 * hi;
                f32x16 acc = MFMA32(gld16(kp), id0, zero16());
                acc = MFMA32(gld16(kp + 16), id1, acc);
                float sum = 0.f;
#pragma unroll
                for (int r = 0; r < 16; ++r) { acc[r] *= kwA[32 * ts + crow(r, hi)]; sum += acc[r]; }
                if (td) ks1 += sum; else ks0 += sum;
                kwf[td][ts][0] = PACK_ACC(acc, 0); kwf[td][ts][1] = PACK_ACC(acc, 1);
            }
        ks0 += wshfl_xor(ks0, 32); ks1 += wshfl_xor(ks1, 32);
        if (hi == 0) { aux[192 + r32] = ks0; aux[192 + 32 + r32] = ks1; }
        WAVE_SYNC();
#pragma unroll
        for (int td = 0; td < 2; ++td)
#pragma unroll
            for (int ts = 0; ts < 2; ++ts)
#pragma unroll
                for (int s2 = 0; s2 < 2; ++s2) gst16(ml_fp128(A.P, cg, 512 + h * 64, ((td * 2 + ts) * 2 + s2) * 64 + lane), kwf[td][ts][s2]);
    }
    {
        const int lane = opaque(lane_in), r32 = lane & 31, hi = lane >> 5;
        const bf16x8 id0 = ident_frag(0, r32, hi), id1 = ident_frag(1, r32, hi);
        bf16x8 vf[4][2][2];
#pragma unroll
        for (int te = 0; te < 4; ++te)
#pragma unroll
            for (int ts = 0; ts < 2; ++ts) {
                const bf16* vp = A.P + (size_t)(m0 + 32 * ts + r32) * MP_LD + 1024 + h * 128 + 32 * te + 8 * hi;
                f32x16 acc = MFMA32(gld16(vp), id0, zero16());
                acc = MFMA32(gld16(vp + 16), id1, acc);
                vf[te][ts][0] = PACK_ACC(acc, 0); vf[te][ts][1] = PACK_ACC(acc, 1);
            }
        WAVE_SYNC();
#pragma unroll
        for (int te = 0; te < 4; ++te)
#pragma unroll
            for (int ts = 0; ts < 2; ++ts)
#pragma unroll
                for (int s2 = 0; s2 < 2; ++s2) gst16(ml_fp256(A.P, cg, 1024 + h * 128, ((te * 2 + ts) * 2 + s2) * 64 + lane), vf[te][ts][s2]);
    }
}
DEVI void ml_prep_phase(const Frame& F, const MlArgs& A) {
    LAS unsigned char* wl = F.lds + F.wave * WAVE_LDS;
    for (int item = F.vcu * 8 + F.wave; item < NITEM; item += F.G * 8) ml_prep_item(A, item, F.lane, wl);
}

DEVI void ml_scan_phase(const Frame& F, const MlArgs& A) {
    LAS float* ssb = (LAS float*)F.lds;
    LAS float* nb = (LAS float*)(F.lds + 4096);
    const int w = F.wave;
    for (int bh = F.vcu; bh < NB * NH; bh += F.G) {
        const int b = bh / NH, h = bh % NH;
        f32x16 C[2]; bf16x8 Cf[2][2];
#pragma unroll
        for (int td = 0; td < 2; ++td) { C[td] = zero16(); Cf[td][0] = PACK_ACC(C[td], 0); Cf[td][1] = PACK_ACC(C[td], 1); }
        if (w < 4) nb[w * 64 + F.lane] = 0.f;
        WAVE_SYNC();
        for (int n = 0; n < NCH; ++n) {
            const int cg = b * NCH + n, item = cg * NH + h;
            if (w < 4) {
                const int lane = opaque(F.lane), r32 = lane & 31, hi = lane >> 5;
                const float* aux = A.aux + (size_t)item * ML_AUX;
                const int lo128 = (lane >> 3) * MP_LD + (lane & 7) * 8, lo256 = (lane >> 4) * MP_LD + (lane & 15) * 8, l8 = lane * 8;
                const bf16* Pq = A.P + (size_t)cg * 64 * MP_LD + h * 64; const bf16* Pk = Pq + 512;
                const bf16* Pv = A.P + (size_t)cg * 64 * MP_LD + 1024 + h * 128;
                const bf16* Pt = A.pt + (size_t)item * 4096;
                bf16x8 vT[2][2];
#pragma unroll
                for (int ts = 0; ts < 2; ++ts)
#pragma unroll
                    for (int s2 = 0; s2 < 2; ++s2) vT[ts][s2] = gld16(Pv + (size_t)((((w * 2 + ts) * 2 + s2)) * 4) * MP_LD + lo256);
                f32x16 hT[2];
#pragma unroll
                for (int tt = 0; tt < 2; ++tt) {
                    const int t = 32 * tt + r32;
                    f32x16 acc = zero16(); float qn = 0.f;
#pragma unroll
                    for (int td = 0; td < 2; ++td)
#pragma unroll
                        for (int s = 0; s < 2; ++s) {
                            const bf16x8 qf = gld16(Pq + (size_t)((((tt * 2 + td) * 2 + s)) * 8) * MP_LD + lo128);
                            acc = MFMA32(Cf[td][s], qf, acc);
                            float f[8]; unpack8(qf, f);
                            const int d0 = 32 * td + 16 * s + 4 * hi;
#pragma unroll
                            for (int j = 0; j < 8; ++j) qn += f[j] * nb[w * 64 + d0 + (j & 3) + 8 * (j >> 2)];
                        }
                    qn += wshfl_xor(qn, 32);
                    const float wi = gldf(aux + t), cs = gldf(aux + 64 + t), ef = gldf(aux + 128 + t);
                    acc = acc * wi;
#pragma unroll
                    for (int ts = 0; ts < 2; ++ts)
#pragma unroll
                        for (int s2 = 0; s2 < 2; ++s2) acc = MFMA32(vT[ts][s2], gld16(Pt + (((tt * 2 + ts) * 2 + s2) * 512) + l8), acc);
                    const float den = wi * qn + cs;
                    const float inv = 1.0f / fmaxf(fabsf(den), ef);
                    hT[tt] = acc * inv;
                }
                const float wold = gldf(aux + 256);
#pragma unroll
                for (int td = 0; td < 2; ++td) {
                    f32x16 acc = C[td] * wold;
#pragma unroll
                    for (int ts = 0; ts < 2; ++ts)
#pragma unroll
                        for (int s2 = 0; s2 < 2; ++s2) acc = MFMA32(gld16(Pk + (size_t)((((td * 2 + ts) * 2 + s2)) * 8) * MP_LD + lo128), vT[ts][s2], acc);
                    C[td] = acc; Cf[td][0] = PACK_ACC(acc, 0); Cf[td][1] = PACK_ACC(acc, 1);
                }
                WAVE_SYNC();
                nb[w * 64 + lane] = wold * nb[w * 64 + lane] + gldf(aux + 192 + lane);
#pragma unroll
                for (int tt = 0; tt < 2; ++tt) {
                    float ss = 0.f;
#pragma unroll
                    for (int r = 0; r < 16; ++r) ss += hT[tt][r] * hT[tt][r];
                    ss += wshfl_xor(ss, 32);
                    if (hi == 0) ssb[((n & 1) * 4 + w) * 64 + 32 * tt + r32] = ss;
                }
                WG_BAR();
#pragma unroll
                for (int tt = 0; tt < 2; ++tt) {
                    const int tok = 32 * tt + r32;
                    const LAS float* sp = ssb + (n & 1) * 256 + tok;
                    const float tot = sp[0] + sp[64] + sp[128] + sp[192];
                    const float rs = 1.0f / sqrtf(tot * (1.0f / 128.0f) + NORM_EPS);
                    const size_t mrow = (size_t)(cg * 64 + tok);
#pragma unroll
                    for (int g = 0; g < 4; ++g) {
                        const int e = 32 * w + 8 * g + 4 * hi;
                        const s16x4 og = gld8(A.P + mrow * MP_LD + 2048 + h * 128 + e);
                        const f32x4 gg = gldf4(A.norm_g + h * 128 + e);
                        float o4[4];
#pragma unroll
                        for (int q = 0; q < 4; ++q) o4[q] = hT[tt][4 * g + q] * rs * gg[q] * sigmoid_f(bf2f((unsigned short)og[q]));
                        u32x2 pk; pk.x = pk2(o4[0], o4[1]); pk.y = pk2(o4[2], o4[3]);
                        gst8(A.o + mrow * 1024 + h * 128 + e, __builtin_bit_cast(s16x4, pk));
                    }
                }
            } else {
                WG_BAR();
            }
        }
    }
}

struct DfArgs {
    const bf16* P;
    const float* rope;
    const float* lam_p;
    const float* norm_g;
    bf16* o;
    float lambda_init;
};
constexpr int DP_LD = 3072, DK_ROW = 272, DV_ROW = 136, DK_TILE = 64 * DK_ROW, DV_TILE = 128 * DV_ROW;

struct DfStage { bf16x8 k0, k1, v0, v1; };
DEVI void df_stage_load(const Frame& F, const DfArgs& A, int b, int h, int kt, DfStage& st) {
    const int key = F.tid >> 3, pc = F.tid & 7, pos = kt * 64 + key;
    const bf16* src = A.P + (size_t)(b * SEQ + pos) * DP_LD + 1024 + h * 128 + pc * 16;
    st.k0 = gld16(src); st.k1 = gld16(src + 8);
    const bf16* vsrc = A.P + (size_t)(b * SEQ + kt * 64 + F.lane) * DP_LD + 2048 + h * 128 + F.wave * 16;
    st.v0 = gld16(vsrc); st.v1 = gld16(vsrc + 8);
}
DEVI void df_stage_store(const Frame& F, const DfArgs& A, int kt, const DfStage& st, LAS unsigned char* kb, LAS unsigned char* vb) {
    {
        const int key = F.tid >> 3, pc = F.tid & 7;
        bf16x8 lo = st.k0, hi8 = st.k1;
        if ((pc & 3) == 0) {
            const float* rp = A.rope + (size_t)(kt * 64 + key) * 16;
            const f32x4 c0 = gldf4(rp), c1 = gldf4(rp + 4), s0 = gldf4(rp + 8), s1 = gldf4(rp + 12);
            float x1[8], x2[8]; unpack8(lo, x1); unpack8(hi8, x2);
            float o1[8], o2[8];
#pragma unroll
            for (int i = 0; i < 8; ++i) { const float c = i < 4 ? c0[i & 3] : c1[i & 3], s = i < 4 ? s0[i & 3] : s1[i & 3]; o1[i] = x1[i] * c - x2[i] * s; o2[i] = x1[i] * s + x2[i] * c; }
            lo = pack8f(o1[0], o1[1], o1[2], o1[3], o1[4], o1[5], o1[6], o1[7]); hi8 = pack8f(o2[0], o2[1], o2[2], o2[3], o2[4], o2[5], o2[6], o2[7]);
        }
        *(LAS bf16x8*)(kb + key * DK_ROW + pc * 32) = lo; *(LAS bf16x8*)(kb + key * DK_ROW + pc * 32 + 16) = hi8;
    }
    {
        const int key = F.lane, pc = F.wave;
#pragma unroll
        for (int e = 0; e < 8; ++e) { *(LAS unsigned short*)(vb + (pc * 16 + e) * DV_ROW + key * 2) = (unsigned short)st.v0[e]; *(LAS unsigned short*)(vb + (pc * 16 + 8 + e) * DV_ROW + key * 2) = (unsigned short)st.v1[e]; }
    }
}

DEVI void df_unit(const Frame& F, const DfArgs& A, int b, int h, int qb, float lam) {
    LAS unsigned char* KB = F.lds; LAS unsigned char* VB = F.lds + 2 * DK_TILE;
    const int w = F.wave, sub = w >> 1, c = w & 1;
    const int cw = (qb * 128 + 32 * sub) >> 6;
    const int nt = 2 * qb + 2;
    bf16x8 qf[4];
    {
        const int lane = opaque(F.lane), r32 = lane & 31, hi = lane >> 5;
        const int t = qb * 128 + 32 * sub + r32;
        const bf16* qp = A.P + (size_t)(b * SEQ + t) * DP_LD + h * 128 + c * 64;
        const float* rp = A.rope + (size_t)t * 16;
        const f32x4 c0 = gldf4(rp), c1 = gldf4(rp + 4), s0 = gldf4(rp + 8), s1 = gldf4(rp + 12);
        const float sc = 0.125f * LOG2E;
#pragma unroll
        for (int ks = 0; ks < 4; ++ks) {
            float f[8]; unpack8(gld16(qp + 16 * ks + 8 * hi), f);
            if (ks == 0) {
                float o[8];
#pragma unroll
                for (int i = 0; i < 8; ++i) { const float p = wshfl_xor(f[i], 32); const float cc = i < 4 ? c0[i & 3] : c1[i & 3], ss = i < 4 ? s0[i & 3] : s1[i & 3];
                    o[i] = hi ? (p * ss + f[i] * cc) : (f[i] * cc - p * ss); }
#pragma unroll
                for (int i = 0; i < 8; ++i) f[i] = o[i];
            }
            qf[ks] = pack8f(f[0] * sc, f[1] * sc, f[2] * sc, f[3] * sc, f[4] * sc, f[5] * sc, f[6] * sc, f[7] * sc);
        }
    }
    f32x16 O[4];
#pragma unroll
    for (int te = 0; te < 4; ++te) O[te] = zero16();
    float mrun = -1e30f, lrun = 0.f;
    DfStage st;
    df_stage_load(F, A, b, h, 0, st);
    df_stage_store(F, A, 0, st, KB, VB);
    WG_BAR();
    for (int kt = 0; kt < nt; ++kt) {
        const int cur = kt & 1;
        if (kt + 1 < nt) df_stage_load(F, A, b, h, kt + 1, st);
        if (kt <= cw) {
            const int lane = opaque(F.lane), r32 = lane & 31, hi = lane >> 5;
            const LAS unsigned char* kb = KB + cur * DK_TILE + r32 * DK_ROW + hi * 16 + c * 128;
            const LAS unsigned char* vb = VB + cur * DV_TILE + r32 * DV_ROW + hi * 8;
            f32x16 sT[2];
#pragma unroll
            for (int tk = 0; tk < 2; ++tk) {
                f32x16 acc = zero16();
#pragma unroll
                for (int ks = 0; ks < 4; ++ks) acc = MFMA32(*(const LAS bf16x8*)(kb + tk * 32 * DK_ROW + 32 * ks), qf[ks], acc);
                sT[tk] = acc;
            }
            float mx = sT[0][0];
#pragma unroll
            for (int r = 0; r < 16; ++r) { mx = fmaxf(mx, sT[0][r]); mx = fmaxf(mx, sT[1][r]); }
            mx = fmaxf(mx, wshfl_xor(mx, 32));
            const float mn = fmaxf(mrun, mx), alpha = fast_exp2(mrun - mn);
            mrun = mn;
            float ps = 0.f;
#pragma unroll
            for (int tk = 0; tk < 2; ++tk)
#pragma unroll
                for (int r = 0; r < 16; ++r) { sT[tk][r] = fast_exp2(sT[tk][r] - mn); ps += sT[tk][r]; }
            lrun = lrun * alpha + ps;
            bf16x8 pf[2][2];
#pragma unroll
            for (int tk = 0; tk < 2; ++tk) { pf[tk][0] = PACK_ACC(sT[tk], 0); pf[tk][1] = PACK_ACC(sT[tk], 1); }
#pragma unroll
            for (int te = 0; te < 4; ++te) {
                f32x16 acc = O[te] * alpha;
#pragma unroll
                for (int tk = 0; tk < 2; ++tk)
#pragma unroll
                    for (int s = 0; s < 2; ++s) {
                        const LAS unsigned char* vp = vb + te * 32 * DV_ROW + (32 * tk + 16 * s) * 2;
                        acc = MFMA32(cat8(*(const LAS s16x4*)vp, *(const LAS s16x4*)(vp + 16)), pf[tk][s], acc);
                    }
                O[te] = acc;
            }
        }
        if (kt + 1 < nt) df_stage_store(F, A, kt + 1, st, KB + (cur ^ 1) * DK_TILE, VB + (cur ^ 1) * DV_TILE);
        WG_BAR();
    }
    const int lane = opaque(F.lane), r32 = lane & 31, hi = lane >> 5;
    const float l = lrun + wshfl_xor(lrun, 32);
    const float inv = (c ? lam : 1.0f) / l;
    LAS float* X = (LAS float*)(F.lds + sub * 16384);
    if (c) {
#pragma unroll
        for (int te = 0; te < 4; ++te)
#pragma unroll
            for (int r = 0; r < 16; ++r) X[(te * 16 + r) * 64 + lane] = O[te][r] * inv;
    }
    WG_BAR();
    if (!c) {
        const int t = qb * 128 + 32 * sub + r32;
        float ss = 0.f;
#pragma unroll
        for (int te = 0; te < 4; ++te)
#pragma unroll
            for (int r = 0; r < 16; ++r) { const float v = O[te][r] * inv - X[(te * 16 + r) * 64 + lane]; O[te][r] = v; ss += v * v; }
        ss += wshfl_xor(ss, 32);
        const float rs = (1.0f - A.lambda_init) / sqrtf(ss * (1.0f / 128.0f) + NORM_EPS);
        const size_t mrow = (size_t)(b * SEQ + t);
#pragma unroll
        for (int te = 0; te < 4; ++te)
#pragma unroll
            for (int g = 0; g < 4; ++g) {
                const int e = 32 * te + 8 * g + 4 * hi;
                const f32x4 gg = gldf4(A.norm_g + e);
                u32x2 pk; pk.x = pk2(O[te][4 * g] * rs * gg[0], O[te][4 * g + 1] * rs * gg[1]); pk.y = pk2(O[te][4 * g + 2] * rs * gg[2], O[te][4 * g + 3] * rs * gg[3]);
                gst8(A.o + mrow * 1024 + h * 128 + e, __builtin_bit_cast(s16x4, pk));
            }
    }
    WG_BAR();
}

DEVI void df_phase(const Frame& F, const DfArgs& A) {
    const float p01 = wave_sum(gldf(A.lam_p + F.lane) * gldf(A.lam_p + 64 + F.lane)), p23 = wave_sum(gldf(A.lam_p + 128 + F.lane) * gldf(A.lam_p + 192 + F.lane));
    const float lam = __expf(p01) - __expf(p23) + A.lambda_init;
    constexpr int NQB = SEQ / 128, NU = NB * NH * NQB;
    for (int i = 0;; ++i) {
        const int u = i * F.G + F.vcu; if (u >= NU) break;
        const int bh = u % (NB * NH), k = u / (NB * NH);
        const int qb = (k < NQB / 2) ? (NQB - 1 - k) : (k - NQB / 2);
        df_unit(F, A, bh / NH, bh % NH, qb, lam);
    }
}

DEVI void post_phase(const Frame& F, const float* xin, const float* mbuf, const float* g_post, float* xout, const float* g_pre, bf16* hout) {
    const int gw = F.vcu * 8 + F.wave, NGW = F.G * 8, lane = F.lane;
    for (int m = gw; m < M; m += NGW) {
        f32x4 x[4]; float ss = 0.f;
#pragma unroll
        for (int j = 0; j < 4; ++j) x[j] = gldf4(xin + (size_t)m * D + 4 * lane + 256 * j);
        if (mbuf) {
            f32x4 mv[4];
#pragma unroll
            for (int j = 0; j < 4; ++j) { mv[j] = gldf4(mbuf + (size_t)m * D + 4 * lane + 256 * j); ss += (mv[j].x * mv[j].x + mv[j].y * mv[j].y) + (mv[j].z * mv[j].z + mv[j].w * mv[j].w); }
            const float rs = 1.0f / sqrtf(wave_sum(ss) * (1.0f / D) + NORM_EPS);
#pragma unroll
            for (int j = 0; j < 4; ++j) { const f32x4 g = gldf4(g_post + 4 * lane + 256 * j); x[j] = x[j] + mv[j] * rs * g; }
        }
        if (xout) {
#pragma unroll
            for (int j = 0; j < 4; ++j) gstf4(xout + (size_t)m * D + 4 * lane + 256 * j, x[j]);
        }
        if (hout) {
            float s2 = 0.f;
#pragma unroll
            for (int j = 0; j < 4; ++j) s2 += (x[j].x * x[j].x + x[j].y * x[j].y) + (x[j].z * x[j].z + x[j].w * x[j].w);
            const float r2 = 1.0f / sqrtf(wave_sum(s2) * (1.0f / D) + NORM_EPS);
#pragma unroll
            for (int j = 0; j < 4; ++j) { const f32x4 g = gldf4(g_pre + 4 * lane + 256 * j); const f32x4 v = x[j] * r2 * g;
                u32x2 pk; pk.x = pk2(v.x, v.y); pk.y = pk2(v.z, v.w); gst8(hout + (size_t)m * D + 4 * lane + 256 * j, __builtin_bit_cast(s16x4, pk)); }
        }
    }
}

DEVI void convert_item(const float* W, int K, int ldw, int c0, int ncols, bf16* WT, int r0, LAS float* scr, int item, int lane) {
    const int nblk = (ncols + 31) / 32, kb = item / nblk, nbk = item % nblk, k0 = 64 * kb, n0 = 32 * nbk;
    const bool colok = (n0 + (lane & 31)) < ncols;
#pragma unroll 8
    for (int i = 0; i < 32; ++i) { const int kk = 2 * i + (lane >> 5); scr[kk * 33 + (lane & 31)] = colok ? gldf(W + (size_t)(k0 + kk) * ldw + c0 + n0 + (lane & 31)) : 0.f; }
    WAVE_SYNC();
    const int c = lane & 7;
#pragma unroll
    for (int j = 0; j < 4; ++j) { const int n = (lane >> 3) + 8 * j; const LAS float* s = scr + (8 * c) * 33 + n;
        u32x4 o; o.x = pk2(s[0 * 33], s[1 * 33]); o.y = pk2(s[2 * 33], s[3 * 33]); o.z = pk2(s[4 * 33], s[5 * 33]); o.w = pk2(s[6 * 33], s[7 * 33]);
        if (n0 + n < ncols) gst16(WT + (size_t)(r0 + n0 + n) * K + k0 + 8 * c, __builtin_bit_cast(bf16x8, o)); }
    WAVE_SYNC();
}
DEVI int convert_job(const Frame& F, int base, const float* W, int K, int ldw, int c0, int ncols, bf16* WT) {
    LAS float* scr = (LAS float*)(F.lds + F.wave * WAVE_LDS);
    const int gw = F.vcu * 8 + F.wave, NGW = F.G * 8;
    const int ni = (K / 64) * ((ncols + 31) / 32);
    int first = gw - (base % NGW); if (first < 0) first += NGW;
    for (int it = first; it < ni; it += NGW) convert_item(W, K, ldw, c0, ncols, WT, 0, scr, it, F.lane);
    return base + ni;
}

DEVI void gates_phase(const Frame& F, const bf16* h, const bf16* WgT, float* out) {
    const int gw = F.vcu * 8 + F.wave, NGW = F.G * 8, lane = F.lane, r16 = lane & 15, q = lane >> 4;
    for (int it = gw; it < M / 16; it += NGW) {
        const int m0 = it * 16;
        f32x4 acc = {0.f, 0.f, 0.f, 0.f};
#pragma unroll 8
        for (int ks = 0; ks < 32; ++ks) acc = MFMA16(gld16(h + (size_t)(m0 + r16) * D + 32 * ks + 8 * q), gld16(WgT + (size_t)r16 * D + 32 * ks + 8 * q), acc);
#pragma unroll
        for (int r = 0; r < 4; ++r) out[(size_t)(m0 + 4 * q + r) * 16 + r16] = acc[r];
    }
}

DEVI void rope_phase(const Frame& F, float* tab) {
    const int g = F.vcu * 512 + F.tid, NG = F.G * 512;
    for (int idx = g; idx < SEQ * 8; idx += NG) {
        const int t = idx >> 3, i = idx & 7;
        const float inv = exp2f(-(float)(2 * i) * (1.0f / 16.0f) * 18.931568569324174f);
        const float ang = (float)t * inv;
        tab[t * 16 + i] = cosf(ang); tab[t * 16 + 8 + i] = sinf(ang);
    }
}

#ifndef HOST_EMU
namespace pg8 {
#define PG8_LAS __attribute__((address_space(3)))
typedef unsigned short bf16_t;
constexpr int BM = 256, BK = 64, HALF = 128, HTB = HALF * BK * 2, STAGE_BYTES = 8 * HTB, NXCD = 8, WGM = 8;
__host__ __device__ __forceinline__ int lds_byte(int r, int c) { const int st = (r >> 4) * 2 + (c >> 5), rr = r & 15, cc = c & 31, ob = rr * 64 + cc * 2; return st * 1024 + (ob ^ (((ob >> 9) & 1) << 5)); }
__host__ __device__ __forceinline__ void stage_rc(int b, int& R, int& C) { const int st = b / 1024, sb = b % 1024, swz = sb ^ (((sb >> 9) & 1) << 5); R = (st >> 1) * 16 + swz / 64; C = (st & 1) * 32 + (swz % 64) / 2; }
__host__ __device__ __forceinline__ int perm32(int rho) { const int n = rho >> 4, i = rho & 15; return 8 * (i >> 2) + 4 * n + (i & 3); }
struct Unit { int pm, pn; };
struct Gemm { const bf16_t* A; const bf16_t* Bt; int M, N, K; };
struct StaticOrder {
    int nM, nN, nwg, G, c;
    __host__ __device__ void init(int M_, int N_, int G_, int c_) { nM = M_ / BM; nN = N_ / BM; nwg = nM * nN; G = G_; c = c_; }
    __host__ __device__ bool next(int i, Unit& u) const {
        const long L = (long)i * G + c; if (L >= nwg) return false;
        int wgid = (int)L; { const int q = nwg / NXCD, r = nwg % NXCD, xcd = wgid % NXCD, off = wgid / NXCD; wgid = (xcd < r ? xcd * (q + 1) : r * (q + 1) + (xcd - r) * q) + off; }
        const int nig = WGM * nN, gid = wgid / nig, fm = gid * WGM, gsz = (nM - fm) < WGM ? (nM - fm) : WGM;
        u.pm = fm + ((wgid % nig) % gsz); u.pn = (wgid % nig) / gsz; return true;
    }
    __device__ __forceinline__ void a_ready(const Unit&) const {}
    __device__ __forceinline__ void done(const Unit&) const {}
};
struct EpiF32 {
    static constexpr bool PERM = false, AFTER_DRAIN = false;
    float* C; int ldc;
    __device__ __forceinline__ void operator()(const f32x4 (&acc)[2][2][4][2], const Unit& u, int wr, int wc, int fr, int fq) const {
        const int row0 = u.pm * BM + wr * 64 + fr, col0 = u.pn * BM + wc * 32 + 4 * fq;
#pragma unroll
        for (int ai = 0; ai < 2; ++ai)
#pragma unroll
            for (int m = 0; m < 4; ++m) { float* rowp = C + (size_t)(row0 + ai * HALF + m * 16) * ldc + col0;
#pragma unroll
                for (int bj = 0; bj < 2; ++bj)
#pragma unroll
                    for (int n = 0; n < 2; ++n) *(f32x4*)(rowp + bj * HALF + n * 16) = acc[ai][bj][m][n]; }
    }
};
template <int ACT, bool HALO> struct EpiBf16 {
    static constexpr bool PERM = true, AFTER_DRAIN = false;
    bf16_t* O; int ldc; bf16_t* halo; int halo_cols;
    __device__ __forceinline__ void operator()(const f32x4 (&acc)[2][2][4][2], const Unit& u, int wr, int wc, int fr, int fq) const {
        const int row0 = u.pm * BM + wr * 64 + fr, col0 = u.pn * BM + wc * 32 + 8 * fq;
#pragma unroll
        for (int ai = 0; ai < 2; ++ai)
#pragma unroll
            for (int m = 0; m < 4; ++m) { const int row = row0 + ai * HALF + m * 16; bf16_t* rowp = O + (size_t)row * ldc + col0;
#pragma unroll
                for (int bj = 0; bj < 2; ++bj) { f32x4 v0 = acc[ai][bj][m][0], v1 = acc[ai][bj][m][1];
                    if (ACT == 2) {
#pragma unroll
                        for (int e = 0; e < 4; ++e) { const float a = fmaxf(v0[e], 0.f), b = fmaxf(v1[e], 0.f); v0[e] = a * a; v1[e] = b * b; } }
                    u32x4 w; w.x = pk2(v0[0], v0[1]); w.y = pk2(v0[2], v0[3]); w.z = pk2(v1[0], v1[1]); w.w = pk2(v1[2], v1[3]);
                    *(u32x4*)(rowp + bj * HALF) = w;
                    if (HALO) { if (m == 3 && fr >= 13 && (col0 + bj * HALF) < halo_cols) *(u32x4*)(halo + ((size_t)(row >> 6) * 3 + (fr - 13)) * halo_cols + col0 + bj * HALF) = w; }
                } }
    }
};

template <class Epi, class Sched, bool ALIGN_EPI = false, bool SP2 = false>
__device__ __forceinline__ void gemm_phase(PG8_LAS unsigned char* lds, const Gemm g, const Sched& S, const Epi& E, int tid_in) {
    const int tid = tid_in, wid = __builtin_amdgcn_readfirstlane(tid >> 6), lane = tid & 63, wr = wid >> 2, wc = wid & 3, fr = lane & 15, fq = lane >> 4;
    const int K = g.K, nt = K / BK;
    unsigned voffA[2], voffB[2];
#pragma unroll
    for (int i = 0; i < 2; ++i) { int R, C; stage_rc(tid * 16 + i * 8192, R, C); const int Rb = Epi::PERM ? ((R & ~31) + perm32(R & 31)) : R;
        voffA[i] = (unsigned)(R * K + C) * 2u; voffB[i] = (unsigned)(Rb * K + C) * 2u; }
    const size_t kstep = (size_t)(BK * 2);
    const size_t hstep = (size_t)HALF * K * 2;
    const size_t tstep = 2 * hstep;
    const unsigned ldsw = (unsigned)wid * 1024u;
    const int aoff = lds_byte(wr * 64 + fr, fq * 8), boff = lds_byte(wc * 32 + fr, fq * 8);
#define PG8_SA(b, h) (((b) * 2 + (h)) * HTB)
#define PG8_SB(b, h) ((4 + (b) * 2 + (h)) * HTB)
#define PG8_STAGE(bufoff, gbase, voff) do { _Pragma("unroll") for (int _i = 0; _i < 2; ++_i) \
        __builtin_amdgcn_global_load_lds((const unsigned*)((const char*)(gbase) + (voff)[_i]), (PG8_LAS unsigned*)(lds + (bufoff) + ldsw + _i * 8192), 16, 0, 0); } while (0)
#define PG8_LDA(dst, b, h) do { _Pragma("unroll") for (int m = 0; m < 4; ++m) _Pragma("unroll") for (int k = 0; k < 2; ++k) dst[m][k] = *(const PG8_LAS bf16x8*)(lds + PG8_SA(b, h) + aoff + m * 2048 + k * 1024); } while (0)
#define PG8_LDB(dst, b, h) do { _Pragma("unroll") for (int n = 0; n < 2; ++n) _Pragma("unroll") for (int k = 0; k < 2; ++k) dst[n][k] = *(const PG8_LAS bf16x8*)(lds + PG8_SB(b, h) + boff + n * 2048 + k * 1024); } while (0)
#define PG8_MMA(ai, bj, At, Bt) do { __builtin_amdgcn_s_setprio(1); _Pragma("unroll") for (int m = 0; m < 4; ++m) _Pragma("unroll") for (int n = 0; n < 2; ++n) _Pragma("unroll") for (int k = 0; k < 2; ++k) \
        acc[ai][bj][m][n] = __builtin_amdgcn_mfma_f32_16x16x32_bf16(Bt[n][k], At[m][k], acc[ai][bj][m][n], 0, 0, 0); __builtin_amdgcn_s_setprio(0); } while (0)
#define PG8_WAIT_V(n) asm volatile("s_waitcnt vmcnt(" #n ")" ::: "memory")
#define PG8_WAIT_L(n) asm volatile("s_waitcnt lgkmcnt(" #n ")" ::: "memory")
#define PG8_BAR __builtin_amdgcn_s_barrier()
#define PG8_SCHED __builtin_amdgcn_sched_barrier(0)
    Unit cur, nxt; int ui = 0;
    if (!S.next(0, cur)) return;
    f32x4 acc[2][2][4][2];
#pragma unroll
    for (int a = 0; a < 2; ++a)
#pragma unroll
        for (int b = 0; b < 2; ++b)
#pragma unroll
            for (int m = 0; m < 4; ++m)
#pragma unroll
                for (int n = 0; n < 2; ++n) acc[a][b][m][n] = (f32x4){0.f, 0.f, 0.f, 0.f};
    bf16x8 At[4][2], B0[2][2], B1[2][2];
    const char* cA = (const char*)g.A + (size_t)cur.pm * tstep; const char* cB = (const char*)g.Bt + (size_t)cur.pn * tstep;
    S.a_ready(cur);
    if constexpr (SP2) {
        PG8_STAGE(PG8_SB(0, 0), cB, voffB); PG8_STAGE(PG8_SB(0, 1), cB + hstep, voffB); PG8_STAGE(PG8_SA(0, 0), cA, voffA); PG8_STAGE(PG8_SA(0, 1), cA + hstep, voffA);
        if (wr == 1) PG8_BAR;
        PG8_WAIT_V(2); PG8_BAR;
        PG8_STAGE(PG8_SB(1, 0), cB + kstep, voffB); PG8_STAGE(PG8_SA(1, 0), cA + kstep, voffA); PG8_STAGE(PG8_SB(1, 1), cB + hstep + kstep, voffB);
        PG8_WAIT_V(6); PG8_BAR;
    } else {
        PG8_STAGE(PG8_SB(0, 0), cB, voffB); PG8_STAGE(PG8_SA(0, 0), cA, voffA); PG8_STAGE(PG8_SB(0, 1), cB + hstep, voffB); PG8_STAGE(PG8_SA(0, 1), cA + hstep, voffA);
        if (wr == 1) PG8_BAR;
        PG8_WAIT_V(4); PG8_BAR;
        PG8_STAGE(PG8_SB(1, 0), cB + kstep, voffB); PG8_STAGE(PG8_SA(1, 0), cA + kstep, voffA); PG8_STAGE(PG8_SB(1, 1), cB + hstep + kstep, voffB);
        PG8_WAIT_V(6); PG8_BAR;
    }
    for (;;) {
        const bool has_next = S.next(ui + 1, nxt);
        const char* nA = has_next ? (const char*)g.A + (size_t)nxt.pm * tstep : cA; const char* nB = has_next ? (const char*)g.Bt + (size_t)nxt.pn * tstep : cB;
        for (int t = 0; t < nt; t += 2) {
            const bool last = (t == nt - 2);
            const char* a1 = cA + (size_t)(t + 1) * kstep;
            const char* a2 = last ? nA : cA + (size_t)(t + 2) * kstep; const char* b2 = last ? nB : cB + (size_t)(t + 2) * kstep;
            const char* a3 = a2 + kstep; const char* b3 = b2 + kstep;
            if (last && has_next) S.a_ready(nxt);
            if constexpr (SP2) {
            PG8_LDB(B0, 0, 0); PG8_LDB(B1, 0, 1); PG8_SCHED; PG8_LDA(At, 0, 0); PG8_STAGE(PG8_SA(1, 1), a1 + hstep, voffA);
            PG8_WAIT_V(8); PG8_WAIT_L(0); PG8_BAR; PG8_MMA(0, 0, At, B0); PG8_MMA(0, 1, At, B1); PG8_BAR; PG8_SCHED;
            PG8_LDA(At, 0, 1); PG8_STAGE(PG8_SB(0, 0), b2, voffB); PG8_STAGE(PG8_SB(0, 1), b2 + hstep, voffB); PG8_STAGE(PG8_SA(0, 0), a2, voffA);
            PG8_WAIT_V(8); PG8_WAIT_L(0); PG8_BAR; PG8_MMA(1, 0, At, B0); PG8_MMA(1, 1, At, B1); PG8_BAR; PG8_SCHED;
            PG8_LDB(B0, 1, 0); PG8_LDB(B1, 1, 1); PG8_SCHED; PG8_LDA(At, 1, 0); PG8_STAGE(PG8_SA(0, 1), a2 + hstep, voffA);
            PG8_WAIT_V(8); PG8_WAIT_L(0); PG8_BAR; PG8_MMA(0, 0, At, B0); PG8_MMA(0, 1, At, B1); PG8_BAR; PG8_SCHED;
            PG8_LDA(At, 1, 1); PG8_STAGE(PG8_SB(1, 0), b3, voffB); PG8_STAGE(PG8_SB(1, 1), b3 + hstep, voffB); PG8_STAGE(PG8_SA(1, 0), a3, voffA);
            PG8_WAIT_V(8); PG8_WAIT_L(0); PG8_BAR; PG8_MMA(1, 0, At, B0); PG8_MMA(1, 1, At, B1); PG8_BAR; PG8_SCHED;
            } else {
            PG8_LDB(B0, 0, 0); PG8_SCHED; PG8_LDA(At, 0, 0); PG8_STAGE(PG8_SA(1, 1), a1 + hstep, voffA);
            PG8_WAIT_L(8); PG8_BAR; PG8_WAIT_L(0); PG8_MMA(0, 0, At, B0); PG8_BAR; PG8_SCHED;
            PG8_LDB(B1, 0, 1); PG8_STAGE(PG8_SB(0, 0), b2, voffB);
            PG8_BAR; PG8_WAIT_L(0); PG8_MMA(0, 1, At, B1); PG8_BAR;
            PG8_LDA(At, 0, 1); PG8_STAGE(PG8_SA(0, 0), a2, voffA);
            PG8_BAR; PG8_WAIT_L(0); PG8_MMA(1, 0, At, B0); PG8_BAR; PG8_SCHED;
            PG8_STAGE(PG8_SB(0, 1), b2 + hstep, voffB);
            PG8_WAIT_V(6); PG8_BAR; PG8_MMA(1, 1, At, B1); PG8_BAR;
            PG8_LDB(B0, 1, 0); PG8_SCHED; PG8_LDA(At, 1, 0); PG8_STAGE(PG8_SA(0, 1), a2 + hstep, voffA);
            PG8_WAIT_L(8); PG8_BAR; PG8_WAIT_L(0); PG8_MMA(0, 0, At, B0); PG8_BAR; PG8_SCHED;
            PG8_LDB(B1, 1, 1); PG8_STAGE(PG8_SB(1, 0), b3, voffB);
            PG8_BAR; PG8_WAIT_L(0); PG8_MMA(0, 1, At, B1); PG8_BAR;
            PG8_LDA(At, 1, 1); PG8_STAGE(PG8_SA(1, 0), a3, voffA);
            PG8_BAR; PG8_WAIT_L(0); PG8_MMA(1, 0, At, B0); PG8_BAR; PG8_SCHED;
            PG8_STAGE(PG8_SB(1, 1), b3 + hstep, voffB);
            PG8_WAIT_V(6); PG8_BAR; PG8_MMA(1, 1, At, B1); PG8_BAR;
            }
        }
        if constexpr (ALIGN_EPI) { if (wr == 0) PG8_BAR; }
        if constexpr (!Epi::AFTER_DRAIN) { E(acc, cur, wr, wc, fr, fq); S.done(cur); }
        if (!has_next) break;
#pragma unroll
        for (int a = 0; a < 2; ++a)
#pragma unroll
            for (int b = 0; b < 2; ++b)
#pragma unroll
                for (int m = 0; m < 4; ++m)
#pragma unroll
                    for (int n = 0; n < 2; ++n) acc[a][b][m][n] = (f32x4){0.f, 0.f, 0.f, 0.f};
        cur = nxt; cA = nA; cB = nB; ++ui;
        if constexpr (ALIGN_EPI) { if (wr == 1) PG8_BAR; }
    }
    PG8_WAIT_V(0);
    if constexpr (!ALIGN_EPI) { if (wr == 0) PG8_BAR; }
    PG8_BAR;
#undef PG8_SA
#undef PG8_SB
#undef PG8_STAGE
#undef PG8_LDA
#undef PG8_LDB
#undef PG8_MMA
#undef PG8_WAIT_V
#undef PG8_WAIT_L
#undef PG8_BAR
#undef PG8_SCHED
}
}

#define XB_TMO      128
#define XB_XCNT(j)  (256  + 64 * (j))
#define XB_XSUB(j)  (1280 + 64 * (j))
#define XB_XGEN(j)  (2304 + 64 * (j))
#define XB_TOP      3328
#define XB_TOPGEN   3392
#define XCD_BAR_WORDS 3456
#define XB_SPIN_CAP (1u << 18)
__device__ __forceinline__ unsigned xb_ld(unsigned* p)              { return __hip_atomic_load(p, __ATOMIC_RELAXED, __HIP_MEMORY_SCOPE_AGENT); }
__device__ __forceinline__ unsigned xb_add(unsigned* p, unsigned v) { return __hip_atomic_fetch_add(p, v, __ATOMIC_RELAXED, __HIP_MEMORY_SCOPE_AGENT); }
__device__ __forceinline__ unsigned xb_xcc_id() { return (unsigned)__builtin_amdgcn_s_getreg((3 << 11) | 20) & 0xFu; }
#define XB_SPIN(cond, bar) do { unsigned _sp = 0; while (cond) { __builtin_amdgcn_s_sleep(1); \
    if ((++_sp & 255u) == 0u) { if (xb_ld(&(bar)[XB_TMO])) break; if (_sp > XB_SPIN_CAP) { atomicAdd(&(bar)[XB_TMO], 1u); break; } } } } while (0)
struct XcdBarrier { unsigned* bar; unsigned x; volatile LAS unsigned* st; };
__device__ __forceinline__ XcdBarrier xcd_barrier_post(unsigned* bar, volatile LAS unsigned* st) {
    XcdBarrier b; b.bar = bar; b.x = xb_xcc_id(); b.st = st;
    if (threadIdx.x == 0) (void)xb_add(&bar[XB_XCNT(b.x)], 1u);
    return b;
}
__device__ __forceinline__ void xcd_barrier_complete(unsigned* bar, unsigned x, unsigned& nloc, unsigned& nx) {
    const unsigned G = gridDim.x * gridDim.y * gridDim.z;
    unsigned sum, cnt, mine, sp = 0u;
    for (;;) {
        sum = 0u; cnt = 0u; mine = 0u;
#pragma unroll
        for (unsigned j = 0; j < 16; ++j) { const unsigned c = xb_ld(&bar[XB_XCNT(j)]); sum += c; cnt += (c > 0u) ? 1u : 0u; mine = (j == x) ? c : mine; }
        if (sum == G) break;
        __builtin_amdgcn_s_sleep(1);
        if ((++sp & 255u) == 0u) { if (xb_ld(&bar[XB_TMO])) break; if (sp > XB_SPIN_CAP) { atomicAdd(&bar[XB_TMO], 1u); break; } }
    }
    nloc = mine > 0u ? mine : 1u; nx = cnt > 0u ? cnt : 1u;
}
__device__ __forceinline__ void xcd_barrier(const XcdBarrier& b) {
    asm volatile("s_waitcnt vmcnt(0)" ::: "memory");
    __syncthreads();
    if (threadIdx.x == 0) {
        unsigned* bar = b.bar;
        __builtin_amdgcn_s_waitcnt(0);
        unsigned nloc = b.st[0], nx = b.st[1];
        if (nloc == 0u) { xcd_barrier_complete(bar, b.x, nloc, nx); b.st[0] = nloc; b.st[1] = nx; }
        const unsigned old = xb_add(&bar[XB_XSUB(b.x)], 1u);
        const unsigned gen = old / nloc;
        if (old + 1u == (gen + 1u) * nloc) {
            __builtin_amdgcn_fence(__ATOMIC_RELEASE, "agent");
            asm volatile("s_waitcnt vmcnt(0)" ::: "memory");
            const unsigned og = xb_add(&bar[XB_TOP], 1u);
            const unsigned tg = og / nx;
            if (og + 1u == (tg + 1u) * nx) xb_add(&bar[XB_TOPGEN], 1u);
            else XB_SPIN(xb_ld(&bar[XB_TOPGEN]) == tg, bar);
            __builtin_amdgcn_fence(__ATOMIC_ACQUIRE, "agent");
            xb_add(&bar[XB_XGEN(b.x)], 1u);
            asm volatile("s_waitcnt vmcnt(0)" ::: "memory");
        } else {
            XB_SPIN(xb_ld(&bar[XB_XGEN(b.x)]) == gen, bar);
            __builtin_amdgcn_fence(__ATOMIC_ACQUIRE, "agent");
            asm volatile("s_waitcnt vmcnt(0)" ::: "memory");
        }
    }
    __syncthreads();
}

constexpr size_t MiB = 1u << 20;
constexpr size_t WS_CTL = 0, CTL_ZERO_BYTES = 64 * 1024;
constexpr size_t WS_ROPE = 1 * MiB;
constexpr size_t WS_GATES = 2 * MiB;
constexpr size_t WS_HALO = 3 * MiB;
constexpr size_t WS_SMALL = 7 * MiB + 512 * 1024;
constexpr size_t WS_WIN = 8 * MiB, WS_WOUT = 16 * MiB, WS_W1 = 18 * MiB, WS_W2 = 26 * MiB, WS_WG = 34 * MiB;
constexpr size_t WS_R0 = 36 * MiB;
constexpr size_t WS_P = 68 * MiB;
constexpr size_t WS_E = 196 * MiB;
constexpr size_t WS_END = 260 * MiB;
constexpr int LDS_MISC = 8 * WAVE_LDS;
constexpr int LDS_BYTES = LDS_MISC + 1024;

struct Args { const float* in[18]; float* out; unsigned char* ws; };
typedef const __attribute__((address_space(4))) Args* CArgsP;
__device__ __forceinline__ CArgsP args_ptr() { CArgsP p = (CArgsP)__builtin_amdgcn_kernarg_segment_ptr(); asm volatile("" : "+s"(p)); return p; }

__global__ void __launch_bounds__(512, 2) trunk_fwd(Args a_unused) {
    extern __shared__ __attribute__((aligned(16))) unsigned char lds_raw[];
    Frame F;
    F.lds = (LAS unsigned char*)lds_raw;
    F.tid = threadIdx.x; F.lane = F.tid & 63; F.wave = __builtin_amdgcn_readfirstlane(F.tid >> 6);
    F.G = gridDim.x; { const int bx = blockIdx.x; F.vcu = (F.G % 8 == 0) ? (bx % 8) * (F.G / 8) + bx / 8 : bx; }
    volatile LAS unsigned* MISC = (volatile LAS unsigned*)(F.lds + LDS_MISC);
    if (F.tid < 64) MISC[F.tid] = 0u;
    __syncthreads();
    XcdBarrier bar = xcd_barrier_post((unsigned*)(args_ptr()->ws + WS_CTL), MISC + 8);
#define GRID_BAR() xcd_barrier(bar)
#define REFRAME() CArgsP ap = args_ptr(); unsigned char* ws = ap->ws; (void)ws; F.tid = opaque((int)threadIdx.x); F.lane = F.tid & 63; F.wave = __builtin_amdgcn_readfirstlane(F.tid >> 6)
#define IN(k) (ap->in[k])
    LAS unsigned char* ring = F.lds;

    for (int layer = 0; layer < 4; ++layer) {
        const int kind = layer % 3, j = layer / 3;
        {
            REFRAME();
            const float* win = kind == 0 ? IN(4) + (size_t)j * D * GDN_IN : kind == 1 ? IN(10) : IN(14);
            const int ldin = kind == 0 ? GDN_IN : kind == 1 ? MLSTM_IN : DIFF_IN, nin = kind == 0 ? 4096 : 3072;
            const float* wout = kind == 0 ? IN(9) + (size_t)j * D * D : kind == 1 ? IN(13) : IN(17);
            int cb = 0;
            cb = convert_job(F, cb, win, D, ldin, 0, nin, (bf16*)(ws + WS_WIN));
            cb = convert_job(F, cb, wout, D, D, 0, D, (bf16*)(ws + WS_WOUT));
            cb = convert_job(F, cb, IN(2) + (size_t)layer * D * FF, D, FF, 0, FF, (bf16*)(ws + WS_W1));
            cb = convert_job(F, cb, IN(3) + (size_t)layer * FF * D, FF, D, 0, D, (bf16*)(ws + WS_W2));
            if (kind != 2) cb = convert_job(F, cb, win, D, ldin, nin, 16, (bf16*)(ws + WS_WG));
            const float* norm_g = IN(1); float* X = ap->out;
            if (layer == 0) { rope_phase(F, (float*)(ws + WS_ROPE)); post_phase(F, IN(0), nullptr, nullptr, X, norm_g + (layer * 4 + 0) * D, (bf16*)(ws + WS_R0)); }
            else post_phase(F, X, (const float*)(ws + WS_E), norm_g + ((layer - 1) * 4 + 3) * D, X, norm_g + (layer * 4 + 0) * D, (bf16*)(ws + WS_R0));
        }
        GRID_BAR();
        {
            REFRAME();
            bf16* Hb = (bf16*)(ws + WS_R0); bf16* Pb = (bf16*)(ws + WS_P);
            if (kind != 2) gates_phase(F, Hb, (const bf16*)(ws + WS_WG), (float*)(ws + WS_GATES));
            const int nin = kind == 0 ? 4096 : 3072;
            pg8::Gemm g{Hb, (const bf16*)(ws + WS_WIN), M, nin, D}; pg8::StaticOrder S; S.init(M, nin, F.G, (int)blockIdx.x);
            if (kind == 0) { pg8::EpiBf16<0, true> E{Pb, nin, (bf16*)(ws + WS_HALO), 3072}; pg8::gemm_phase<pg8::EpiBf16<0, true>, pg8::StaticOrder, true, true>(ring, g, S, E, F.tid); }
            else { pg8::EpiBf16<0, false> E{Pb, nin, nullptr, 0}; pg8::gemm_phase<pg8::EpiBf16<0, false>, pg8::StaticOrder, true, true>(ring, g, S, E, F.tid); }
        }
        GRID_BAR();
        if (kind == 0) {
            { REFRAME();
              GdnArgs A{(bf16*)(ws + WS_P), (const float*)(ws + WS_GATES), (const bf16*)(ws + WS_HALO), IN(5) + (size_t)j * 4 * 3072, IN(6) + j * 8, IN(7) + j * 8, IN(8) + j * 128, (bf16*)(ws + WS_R0), (bf16*)(ws + WS_E), (float*)(ws + WS_SMALL), (bf16*)(ws + WS_E + 16 * MiB)};
              gdn_prep_phase(F, A); }
            GRID_BAR();
            { REFRAME();
              GdnArgs A{(bf16*)(ws + WS_P), (const float*)(ws + WS_GATES), (const bf16*)(ws + WS_HALO), IN(5) + (size_t)j * 4 * 3072, IN(6) + j * 8, IN(7) + j * 8, IN(8) + j * 128, (bf16*)(ws + WS_R0), (bf16*)(ws + WS_E), (float*)(ws + WS_SMALL), (bf16*)(ws + WS_E + 16 * MiB)};
              gdn_scan_phase(F, A); }
        } else if (kind == 1) {
            { REFRAME();
              MlArgs A{(bf16*)(ws + WS_P), (const float*)(ws + WS_GATES), IN(11), IN(12), (bf16*)(ws + WS_R0), (float*)(ws + WS_E), (bf16*)(ws + WS_E + 16 * MiB)};
              ml_prep_phase(F, A); }
            GRID_BAR();
            { REFRAME();
              MlArgs A{(bf16*)(ws + WS_P), (const float*)(ws + WS_GATES), IN(11), IN(12), (bf16*)(ws + WS_R0), (float*)(ws + WS_E), (bf16*)(ws + WS_E + 16 * MiB)};
              ml_scan_phase(F, A); }
        } else {
            REFRAME();
            DfArgs A{(const bf16*)(ws + WS_P), (const float*)(ws + WS_ROPE), IN(15), IN(16), (bf16*)(ws + WS_E + 16 * MiB), 0.8f - 0.6f * 0.5488116360940264f};
            df_phase(F, A);
        }
        GRID_BAR();
        {
            REFRAME();
            pg8::Gemm g{(const bf16*)(ws + WS_E + 16 * MiB), (const bf16*)(ws + WS_WOUT), M, D, D}; pg8::StaticOrder S; S.init(M, D, F.G, (int)blockIdx.x);
            pg8::EpiF32 E{(float*)(ws + WS_P), D}; pg8::gemm_phase<pg8::EpiF32, pg8::StaticOrder, false, true>(ring, g, S, E, F.tid);
        }
        GRID_BAR();
        {
            REFRAME();
            const float* norm_g = IN(1); float* X = ap->out;
            post_phase(F, X, (const float*)(ws + WS_P), norm_g + (layer * 4 + 1) * D, X, norm_g + (layer * 4 + 2) * D, (bf16*)(ws + WS_R0));
        }
        GRID_BAR();
        {
            REFRAME();
            pg8::Gemm g{(const bf16*)(ws + WS_R0), (const bf16*)(ws + WS_W1), M, FF, D}; pg8::StaticOrder S; S.init(M, FF, F.G, (int)blockIdx.x);
            pg8::EpiBf16<2, false> E{(bf16*)(ws + WS_P), FF, nullptr, 0}; pg8::gemm_phase<pg8::EpiBf16<2, false>, pg8::StaticOrder, true, true>(ring, g, S, E, F.tid);
        }
        GRID_BAR();
        {
            REFRAME();
            pg8::Gemm g{(const bf16*)(ws + WS_P), (const bf16*)(ws + WS_W2), M, D, FF}; pg8::StaticOrder S; S.init(M, D, F.G, (int)blockIdx.x);
            pg8::EpiF32 E{(float*)(ws + WS_E), D}; pg8::gemm_phase<pg8::EpiF32, pg8::StaticOrder, false, true>(ring, g, S, E, F.tid);
        }
        GRID_BAR();
    }
    {
        REFRAME();
        const float* norm_g = IN(1); float* X = ap->out;
        post_phase(F, X, (const float*)(ws + WS_E), norm_g + (3 * 4 + 3) * D, X, nullptr, nullptr);
    }
#undef GRID_BAR
#undef REFRAME
#undef IN
}

extern "C" void kernel_launch(void* const* d_in, const int* in_sizes, int n_in, void* d_out, int out_size, void* d_ws, size_t ws_size, hipStream_t stream) {
    static int grid = 0;
    if (grid == 0) {
        if (n_in != 18 || out_size != M * D || ws_size < WS_END) { fprintf(stderr, "kernel_launch: unexpected shapes (n_in %d out %d ws %zu)\n", n_in, out_size, ws_size); grid = -1; return; }
        int dev = 0, cus = 0, per_cu = 0;
        if (hipGetDevice(&dev) != hipSuccess || hipDeviceGetAttribute(&cus, hipDeviceAttributeMultiprocessorCount, dev) != hipSuccess) { grid = -1; return; }
        if (hipFuncSetAttribute((const void*)trunk_fwd, hipFuncAttributeMaxDynamicSharedMemorySize, LDS_BYTES) != hipSuccess) { fprintf(stderr, "kernel_launch: hipFuncSetAttribute failed\n"); grid = -1; return; }
        if (hipOccupancyMaxActiveBlocksPerMultiprocessor(&per_cu, (const void*)trunk_fwd, 512, LDS_BYTES) != hipSuccess || per_cu < 1) { fprintf(stderr, "kernel_launch: occupancy query says %d\n", per_cu); }
        (void)hipGetLastError();
        grid = cus;
    }
    if (grid < 0) return;
    (void)hipMemsetAsync((char*)d_ws + WS_CTL, 0, CTL_ZERO_BYTES, stream);
    Args a{};
    for (int i = 0; i < 18; ++i) a.in[i] = (const float*)d_in[i];
    a.out = (float*)d_out; a.ws = (unsigned char*)d_ws;
    void* params[] = {&a};
    hipError_t e = hipLaunchCooperativeKernel((const void*)trunk_fwd, dim3(grid), dim3(512), params, LDS_BYTES, stream);
    if (e != hipSuccess) fprintf(stderr, "kernel_launch: cooperative launch failed: %s (grid %d)\n", hipGetErrorString(e), grid);
}
#endif
```
